# Optimizing an MI355X kernel written in HIP

```python
import math
import jax, jax.numpy as jnp
from jax import lax
import numpy as np

D_MODEL = 1024
BATCH = 8
SEQ = 2048
DEPTH = 1

HEAD_DIM = 64
MIX_WIDTH = D_MODEL
ATTN_WIDTH = MIX_WIDTH // 2
RET_WIDTH = MIX_WIDTH - ATTN_WIDTH
N_ATTN_HEADS = ATTN_WIDTH // HEAD_DIM
N_RET_HEADS = RET_WIDTH // HEAD_DIM
PROJ_WIDTH = 3 * ATTN_WIDTH + 4 * RET_WIDTH
ATTN_BRANCHES = ((128, 1), (512, 4), (2048, 16))
ATTN_BLOCK = 64
N_BUCKETS = 32
REL_MAX_DIST = 1024
RET_CHUNK = 128
ROPE_BASE = 10000.0
N_GROUPS = 4
EXPERTS_PER_GROUP = 4
N_EXPERTS = N_GROUPS * EXPERTS_PER_GROUP
EXPERT_FF = D_MODEL // 2
TOP_K_INNER = 2
EPS = 1e-6
NEG_INF = -1e30

kernel_name = 'hybrid_dilated_attn_retention_hier_moe'


def _rms_norm(x, gain):
    xf = x.astype(jnp.float32)
    y = xf * lax.rsqrt(jnp.mean(xf * xf, axis=-1, keepdims=True) + EPS)
    return (y * gain.astype(jnp.float32)).astype(x.dtype)


def _to_heads(t, n_heads):
    b, s, _ = t.shape
    return t.reshape(b, s, n_heads, -1).transpose(0, 2, 1, 3)


def _from_heads(t):
    b, h, s, hd = t.shape
    return t.transpose(0, 2, 1, 3).reshape(b, s, h * hd)


def _t5_bucket(rel):
    half = N_BUCKETS // 2
    max_exact = half // 2
    offset = jnp.where(rel > 0, half, 0)
    n = jnp.abs(rel)
    nf = jnp.maximum(n, 1).astype(jnp.float32)
    large = max_exact + (jnp.log(nf / max_exact) / math.log(REL_MAX_DIST / max_exact)
                         * (half - max_exact)).astype(jnp.int32)
    large = jnp.minimum(large, half - 1)
    return offset + jnp.where(n < max_exact, n, large)


def _dilated_window_branch(q, k, v, rel_bias, window, dilation):
    b, h, s, hd = q.shape
    radius = (window // 2) // dilation
    sub_len = s // dilation
    n_blk = -(-sub_len // ATTN_BLOCK)
    pad_len = n_blk * ATTN_BLOCK - sub_len

    def to_sub(t):
        return t.reshape(b, h, sub_len, dilation, hd).transpose(0, 1, 3, 2, 4)

    qs = jnp.pad(to_sub(q), ((0, 0), (0, 0), (0, 0), (0, pad_len), (0, 0)))
    qs = qs.reshape(b, h, dilation, n_blk, ATTN_BLOCK, hd)

    def neighbour_blocks(t):
        tp = jnp.pad(to_sub(t), ((0, 0), (0, 0), (0, 0), (ATTN_BLOCK, pad_len + ATTN_BLOCK), (0, 0)))
        tp = tp.reshape(b, h, dilation, n_blk + 2, ATTN_BLOCK, hd)
        return jnp.concatenate([tp[:, :, :, :-2], tp[:, :, :, 1:-1], tp[:, :, :, 2:]], axis=4)

    kb = neighbour_blocks(k)
    vb = neighbour_blocks(v)
    logits = jnp.einsum('bhrnqd,bhrnkd->bhrnqk', qs, kb).astype(jnp.float32)

    rel_sub = jnp.arange(3 * ATTN_BLOCK)[None, :] - ATTN_BLOCK - jnp.arange(ATTN_BLOCK)[:, None]
    bias = rel_bias[_t5_bucket(rel_sub * dilation)].astype(jnp.float32)
    bias = jnp.transpose(bias, (2, 0, 1))
    key_pos = (jnp.arange(n_blk)[:, None] - 1) * ATTN_BLOCK + jnp.arange(3 * ATTN_BLOCK)[None, :]
    valid = (jnp.abs(rel_sub) <= radius)[None] & ((key_pos >= 0) & (key_pos < sub_len))[:, None, :]
    logits = jnp.where(valid, logits + bias[None, :, None, None], NEG_INF)

    m = jnp.max(logits, axis=-1, keepdims=True)
    p = jnp.exp(logits - m)
    denom = jnp.sum(p, axis=-1, keepdims=True)
    out = jnp.einsum('bhrnqk,bhrnkd->bhrnqd', p, vb.astype(jnp.float32)) / denom
    lse = (m + jnp.log(denom))[..., 0]

    def from_sub(t):
        tail = t.shape[5:]
        t = t.reshape((b, h, dilation, n_blk * ATTN_BLOCK) + tail)[:, :, :, :sub_len]
        t = jnp.moveaxis(t, 2, 3)
        return t.reshape((b, h, s) + tail)

    return from_sub(out), from_sub(lse)


def _dilated_attention(q, k, v, rel_bias):
    outs, lses = [], []
    for window, dilation in ATTN_BRANCHES:
        o, l = _dilated_window_branch(q, k, v, rel_bias, window, dilation)
        outs.append(o)
        lses.append(l)
    w = jax.nn.softmax(jnp.stack(lses, axis=0), axis=0)
    return jnp.sum(w[..., None] * jnp.stack(outs, axis=0), axis=0)


def _rotary(t, pos):
    half = t.shape[-1] // 2
    inv = ROPE_BASE ** (-jnp.arange(half, dtype=jnp.float32) / half)
    ang = pos[:, None] * inv[None, :]
    cos, sin = jnp.cos(ang), jnp.sin(ang)
    t1, t2 = t[..., :half], t[..., half:]
    return jnp.concatenate([t1 * cos - t2 * sin, t1 * sin + t2 * cos], axis=-1)


def _chunk_retention(q, k, v, log_g, include_diag):
    b, h, s, hd = q.shape
    nc = s // RET_CHUNK
    qc = q.reshape(b, h, nc, RET_CHUNK, hd)
    kc = k.reshape(b, h, nc, RET_CHUNK, hd)
    vc = v.reshape(b, h, nc, RET_CHUNK, v.shape[-1])
    idx = jnp.arange(RET_CHUNK, dtype=jnp.float32)
    rel = idx[:, None] - idx[None, :]
    mask = (rel >= 0) if include_diag else (rel > 0)
    decay = jnp.where(mask[None], jnp.exp(log_g[:, None, None] * jnp.maximum(rel, 0.0)[None]), 0.0)
    scores = jnp.einsum('bhncd,bhnkd->bhnck', qc, kc) * decay[None, :, None]
    intra = jnp.einsum('bhnck,bhnke->bhnce', scores, vc)
    k_dec = jnp.exp(log_g[:, None] * (RET_CHUNK - 1 - idx)[None])
    kv = jnp.einsum('bhnkd,bhnke->bhnde', kc * k_dec[None, :, None, :, None], vc)
    chunk_decay = jnp.exp(log_g * RET_CHUNK)[None, :, None, None]

    def step(state, kv_n):
        return state * chunk_decay + kv_n, state

    init = jnp.zeros((b, h, hd, v.shape[-1]), jnp.float32)
    _, states = lax.scan(step, init, jnp.moveaxis(kv, 2, 0))
    states = jnp.moveaxis(states, 0, 2)
    q_dec = jnp.exp(log_g[:, None] * (idx + 1.0)[None])
    cross = jnp.einsum('bhncd,bhnde->bhnce', qc * q_dec[None, :, None, :, None], states)
    return (intra + cross).reshape(b, h, s, v.shape[-1])


def _retention(q, k, v, g, decay_fwd, decay_bwd):
    s, hd = q.shape[2], q.shape[3]
    pos = jnp.arange(s, dtype=jnp.float32)
    qf = _rotary(q.astype(jnp.float32), pos)
    kf = _rotary(k.astype(jnp.float32), pos) * (hd ** -0.5)
    vf = v.astype(jnp.float32)
    log_g_f = -jnp.exp(decay_fwd.astype(jnp.float32))
    log_g_b = -jnp.exp(decay_bwd.astype(jnp.float32))
    y_f = _chunk_retention(qf, kf, vf, log_g_f, True)
    flip = lambda t: jnp.flip(t, axis=2)
    y_b = flip(_chunk_retention(flip(qf), flip(kf), flip(vf), log_g_b, False))
    y = y_f + y_b
    y = y * lax.rsqrt(jnp.mean(y * y, axis=-1, keepdims=True) + EPS)
    y = _from_heads(y) * jax.nn.silu(g.astype(jnp.float32))
    return y.astype(g.dtype)


def _hier_moe(xn, w_g, b_g, w_e, b_e, w1, w3, w2):
    b, s, d = xn.shape
    t = xn.reshape(b * s, d)
    group_logits = (t @ w_g).astype(jnp.float32) + b_g.astype(jnp.float32)
    group_probs = jax.nn.softmax(group_logits, axis=-1)
    p_group, g_idx = lax.top_k(group_probs, 1)
    expert_logits = jnp.einsum('td,gde->tge', t, w_e).astype(jnp.float32) + b_e.astype(jnp.float32)
    chosen = jnp.take_along_axis(expert_logits, g_idx[:, :, None], axis=1)[:, 0]
    top_vals, top_idx = lax.top_k(chosen, TOP_K_INNER)
    top_p = jax.nn.softmax(top_vals, axis=-1)
    inner = jnp.sum(jax.nn.one_hot(top_idx, EXPERTS_PER_GROUP) * top_p[..., None], axis=1)
    gates = jax.nn.one_hot(g_idx[:, 0], N_GROUPS)[:, :, None] * (p_group[:, :, None] * inner[:, None, :])
    out = jnp.zeros((b * s, d), jnp.float32)
    for grp in range(N_GROUPS):
        sl = slice(grp * EXPERTS_PER_GROUP, (grp + 1) * EXPERTS_PER_GROUP)
        hidden = jax.nn.silu(jnp.einsum('td,edf->tef', t, w1[sl])) * jnp.einsum('td,edf->tef', t, w3[sl])
        hidden = hidden.astype(jnp.float32) * gates[:, grp, :, None]
        out = out + jnp.einsum('tef,efd->td', hidden, w2[sl].astype(jnp.float32))
    return out.reshape(b, s, d).astype(xn.dtype)


def setup_inputs(seed: int = 0) -> dict:
    key = jax.random.key(seed)
    ks = jax.random.split(key, 20)
    f32 = jnp.float32
    nrm = lambda k, shape, scale: jax.random.normal(k, shape, f32) * scale
    heads = jnp.arange(N_RET_HEADS, dtype=f32)
    base_decay = jnp.log(-jnp.log1p(-(2.0 ** (-5.0 - heads))))
    return {
        'x': nrm(ks[0], (BATCH, SEQ, D_MODEL), 1.0),
        'w_in': nrm(ks[1], (DEPTH, D_MODEL, PROJ_WIDTH), D_MODEL ** -0.5),
        'w_out': nrm(ks[2], (DEPTH, MIX_WIDTH, D_MODEL), MIX_WIDTH ** -0.5),
        'norm_mix': 1.0 + nrm(ks[3], (DEPTH, D_MODEL), 0.02),
        'norm_ffn': 1.0 + nrm(ks[4], (DEPTH, D_MODEL), 0.02),
        'norm_final': 1.0 + nrm(ks[5], (D_MODEL,), 0.02),
        'attn_out_gain': 1.0 + nrm(ks[6], (DEPTH, ATTN_WIDTH), 0.02),
        'rel_bias': nrm(ks[7], (N_BUCKETS, N_ATTN_HEADS), 0.2),
        'ret_decay_fwd': base_decay[None] + nrm(ks[8], (DEPTH, N_RET_HEADS), 0.05),
        'ret_decay_bwd': base_decay[None] + nrm(ks[9], (DEPTH, N_RET_HEADS), 0.05),
        'router_group_w': nrm(ks[10], (DEPTH, D_MODEL, N_GROUPS), D_MODEL ** -0.5),
        'router_group_b': nrm(ks[11], (DEPTH, N_GROUPS), 0.01),
        'router_expert_w': nrm(ks[12], (DEPTH, N_GROUPS, D_MODEL, EXPERTS_PER_GROUP), D_MODEL ** -0.5),
        'router_expert_b': nrm(ks[13], (DEPTH, N_GROUPS, EXPERTS_PER_GROUP), 0.01),
        'expert_w1': nrm(ks[14], (DEPTH, N_EXPERTS, D_MODEL, EXPERT_FF), D_MODEL ** -0.5),
        'expert_w3': nrm(ks[15], (DEPTH, N_EXPERTS, D_MODEL, EXPERT_FF), D_MODEL ** -0.5),
        'expert_w2': nrm(ks[16], (DEPTH, N_EXPERTS, EXPERT_FF, D_MODEL), EXPERT_FF ** -0.5),
    }


def reference(x, w_in, w_out, norm_mix, norm_ffn, norm_final, attn_out_gain, rel_bias,
              ret_decay_fwd, ret_decay_bwd, router_group_w, router_group_b,
              router_expert_w, router_expert_b, expert_w1, expert_w3, expert_w2):
    a = ATTN_WIDTH
    r = RET_WIDTH
    split_at = [a, 2 * a, 3 * a, 3 * a + r, 3 * a + 2 * r, 3 * a + 3 * r]
    h = x
    for layer in range(DEPTH):
        xn = _rms_norm(h, norm_mix[layer])
        proj = xn @ w_in[layer]
        aq, ak, av, rq, rk, rv, rg = jnp.split(proj, split_at, axis=-1)
        attn = _dilated_attention(_to_heads(aq, N_ATTN_HEADS) * (HEAD_DIM ** -0.5),
                                  _to_heads(ak, N_ATTN_HEADS), _to_heads(av, N_ATTN_HEADS), rel_bias)
        attn = _rms_norm(_from_heads(attn).astype(x.dtype), attn_out_gain[layer])
        ret = _retention(_to_heads(rq, N_RET_HEADS), _to_heads(rk, N_RET_HEADS),
                         _to_heads(rv, N_RET_HEADS), rg, ret_decay_fwd[layer], ret_decay_bwd[layer])
        h = h + jnp.concatenate([attn, ret], axis=-1) @ w_out[layer]
        hn = _rms_norm(h, norm_ffn[layer])
        h = h + _hier_moe(hn, router_group_w[layer], router_group_b[layer],
                          router_expert_w[layer], router_expert_b[layer],
                          expert_w1[layer], expert_w3[layer], expert_w2[layer])
    return _rms_norm(h, norm_final)
```

```cpp
#include <hip/hip_runtime.h>
#include <cstdio>
#include <cstdint>

#ifndef MK_PER_PHASE
#define MK_PER_PHASE 1
#endif

#define GAS __attribute__((address_space(1)))
#define LAS __attribute__((address_space(3)))
typedef unsigned short bf16;
typedef unsigned v4u __attribute__((ext_vector_type(4)));
typedef unsigned v2u __attribute__((ext_vector_type(2)));
typedef float f32x4 __attribute__((ext_vector_type(4)));
typedef float f32x2 __attribute__((ext_vector_type(2)));
typedef short bf16x8 __attribute__((ext_vector_type(8)));
typedef GAS unsigned gu32;
#define RLX_AGENT __ATOMIC_RELAXED, __HIP_MEMORY_SCOPE_AGENT
#define LDS_WAIT() asm volatile("s_waitcnt lgkmcnt(0)" ::: "memory")
#define VM_WAIT() asm volatile("s_waitcnt vmcnt(0)" ::: "memory")

constexpr int NB = 8, SEQ = 2048, D = 1024, M = NB * SEQ, PW = 3584, NH = 8, HD = 64;
constexpr int C_AQ = 0, C_AK = 512, C_AV = 1024, C_RQ = 1536, C_RK = 2048, C_RV = 2560, C_RG = 3072;
constexpr int NE = 16, FF = 512, NCLS = 24, LCAP = 16384;
constexpr float EPS = 1e-6f;
constexpr int RC = 128, NCH = SEQ / RC;

constexpr size_t MiB = 1u << 20;
constexpr size_t WS_CTL = 0, CTL_ZERO_BYTES = 1 * MiB;
constexpr size_t WS_COS = 1 * MiB, WS_SIN = WS_COS + 256 * 1024, WS_BIAS = WS_SIN + 256 * 1024;
constexpr size_t WS_WIN = 4 * MiB, WS_WOUT = 11 * MiB, WS_W1 = 13 * MiB, WS_W3 = 29 * MiB, WS_W2 = 45 * MiB;
constexpr size_t WS_XN = 61 * MiB;
constexpr size_t WS_PROJ = 93 * MiB;
constexpr size_t WS_MIX = 205 * MiB;
constexpr size_t WS_LIST = 237 * MiB;
constexpr size_t WS_END = 243 * MiB;
constexpr size_t DO_ATTO = 0, DO_ATTL = 48 * MiB;
constexpr int CW_TMO = 0, CW_CODE = 1, CW_BAR = 4096, CW_CLS = 16384;

constexpr int RING_OFF = 0, RING_BYTES = 131072;
constexpr int LDSCTL_OFF = RING_BYTES, MISC_OFF = LDSCTL_OFF + 320;
constexpr int MOETAB_OFF = LDSCTL_OFF + 1024;
constexpr int RT_OFF = LDSCTL_OFF + 2048;
constexpr int LDS_BYTES = 147456;
constexpr int NWAVES = 8;

struct ListEnt { int tok; float glo, ghi; int pad; };

__device__ __forceinline__ unsigned f2bf(float f) { unsigned u = __builtin_bit_cast(unsigned, f); return (u + 0x7fffu + ((u >> 16) & 1u)) >> 16; }
__device__ __forceinline__ unsigned pk2(float lo, float hi) { return f2bf(lo) | (f2bf(hi) << 16); }
__device__ __forceinline__ float bf_lo(unsigned w) { return __builtin_bit_cast(float, w << 16); }
__device__ __forceinline__ float bf_hi(unsigned w) { return __builtin_bit_cast(float, w & 0xffff0000u); }
__device__ __forceinline__ float wave_sum(float v) {
#pragma unroll
    for (int o = 1; o < 64; o <<= 1) v += __shfl_xor(v, o);
    return v;
}

namespace pg8 {
#define PG8_LAS __attribute__((address_space(3)))
typedef unsigned short bf16_t;
typedef unsigned u32x4 __attribute__((ext_vector_type(4)));
constexpr int BM = 256, BK = 64, HALF = 128, HTB = HALF * BK * 2, STAGE_BYTES = 8 * HTB, NXCD = 8, WGM = 8;

__host__ __device__ __forceinline__ int lds_byte(int r, int c) { const int st = (r >> 4) * 2 + (c >> 5), rr = r & 15, cc = c & 31, ob = rr * 64 + cc * 2; return st * 1024 + (ob ^ (((ob >> 9) & 1) << 5)); }
__host__ __device__ __forceinline__ void stage_rc(int b, int& R, int& C) { const int st = b / 1024, sb = b % 1024, swz = sb ^ (((sb >> 9) & 1) << 5); R = (st >> 1) * 16 + swz / 64; C = (st & 1) * 32 + (swz % 64) / 2; }
__host__ __device__ __forceinline__ int perm32(int rho) { const int n = rho >> 4, i = rho & 15; return 8 * (i >> 2) + 4 * n + (i & 3); }

struct Unit { int pm, pn, x0, x1; };

__device__ __forceinline__ int xcd_remap(int L, int nwg) { const int q = nwg / NXCD, r = nwg % NXCD, xcd = L % NXCD, off = L / NXCD; return (xcd < r ? xcd * (q + 1) : r * (q + 1) + (xcd - r) * q) + off; }

struct DenseOrder {
    static constexpr bool GATHER = false;
    const bf16_t* A; const bf16_t* Bt; int ldA, ldB; int nM, nN, nwg, G, c;
    __device__ void init(const bf16_t* A_, const bf16_t* Bt_, int M_, int N_, int ldA_, int ldB_, int G_, int c_) { A = A_; Bt = Bt_; ldA = ldA_; ldB = ldB_; nM = M_ / BM; nN = N_ / BM; nwg = nM * nN; G = G_; c = c_; }
    __device__ __forceinline__ bool next(int i, Unit& u) const {
        const long L = (long)i * G + c; if (L >= nwg) return false;
        const int wgid = xcd_remap((int)L, nwg);
        const int nig = WGM * nN, gid = wgid / nig, fm = gid * WGM, gsz = (nM - fm) < WGM ? (nM - fm) : WGM;
        u.pm = fm + ((wgid % nig) % gsz); u.pn = (wgid % nig) / gsz; u.x0 = 0; u.x1 = 0; return true;
    }
    __device__ __forceinline__ const char* a_base(const Unit& u) const { return (const char*)A + (size_t)u.pm * BM * ldA * 2; }
    __device__ __forceinline__ void a_voff(const Unit&, const int (&R)[2], const int (&C)[2], unsigned (&v)[2][2]) const {
#pragma unroll
        for (int h = 0; h < 2; ++h)
#pragma unroll
            for (int i = 0; i < 2; ++i) v[h][i] = (unsigned)((h * HALF + R[i]) * ldA + C[i]) * 2u;
    }
    __device__ __forceinline__ const char* b_base(const Unit& u, int half, int kt) const { return (const char*)Bt + ((size_t)(u.pn * BM + half * HALF) * ldB + (size_t)kt * BK) * 2; }
};

__device__ __forceinline__ unsigned cvt_pk_bf16(float lo, float hi) { unsigned r; asm volatile("v_cvt_pk_bf16_f32 %0, %1, %2" : "=v"(r) : "v"(lo), "v"(hi)); return r; }

struct EpiBf16 {
    static constexpr bool PERM = true;
    bf16_t* O; int ldc;
    __device__ __forceinline__ void operator()(const f32x4 (&acc)[2][2][4][2], const Unit& u, int wr, int wc, int fr, int fq) const {
        const int row0 = u.pm * BM + wr * 64 + fr; const int col0 = u.pn * BM + wc * 32 + 8 * fq;
#pragma unroll
        for (int ai = 0; ai < 2; ++ai)
#pragma unroll
            for (int m = 0; m < 4; ++m) { bf16_t* rowp = O + (size_t)(row0 + ai * HALF + m * 16) * ldc + col0;
#pragma unroll
                for (int bj = 0; bj < 2; ++bj) { const f32x4 v0 = acc[ai][bj][m][0], v1 = acc[ai][bj][m][1];
                    u32x4 w; w.x = cvt_pk_bf16(v0[0], v0[1]); w.y = cvt_pk_bf16(v0[2], v0[3]); w.z = cvt_pk_bf16(v1[0], v1[1]); w.w = cvt_pk_bf16(v1[2], v1[3]);
                    *(u32x4*)(rowp + bj * HALF) = w; } }
    }
};
struct EpiResF32 {
    static constexpr bool PERM = false;
    const float* res; float* out; int ldc;
    __device__ __forceinline__ void operator()(const f32x4 (&acc)[2][2][4][2], const Unit& u, int wr, int wc, int fr, int fq) const {
        const int row0 = u.pm * BM + wr * 64 + fr, col0 = u.pn * BM + wc * 32 + 4 * fq;
#pragma unroll
        for (int ai = 0; ai < 2; ++ai)
#pragma unroll
            for (int m = 0; m < 4; ++m) { const size_t off = (size_t)(row0 + ai * HALF + m * 16) * ldc + col0;
#pragma unroll
                for (int bj = 0; bj < 2; ++bj)
#pragma unroll
                    for (int n = 0; n < 2; ++n) { const f32x4 r = *(const f32x4*)(res + off + bj * HALF + n * 16); *(f32x4*)(out + off + bj * HALF + n * 16) = r + acc[ai][bj][m][n]; }
                asm volatile("" ::: "memory"); }
    }
};

template <class Epi, class Sched, bool ALIGN_EPI, bool SP2>
__device__ __forceinline__ void gemm_phase(PG8_LAS unsigned char* lds, const Sched& S, const Epi& E, const int ldB, const int K) {
    const int tid = threadIdx.x, wid = __builtin_amdgcn_readfirstlane(tid >> 6), lane = tid & 63, wr = wid >> 2, wc = wid & 3, fr = lane & 15, fq = lane >> 4;
    const int nt = K / BK;
    int sR[2], sC[2]; unsigned voffB[2];
#pragma unroll
    for (int i = 0; i < 2; ++i) { stage_rc(tid * 16 + i * 8192, sR[i], sC[i]); const int Rb = Epi::PERM ? ((sR[i] & ~31) + perm32(sR[i] & 31)) : sR[i];
        voffB[i] = (unsigned)(Rb * ldB + sC[i]) * 2u; }
    const size_t kstep = (size_t)(BK * 2);
    const unsigned ldsw = (unsigned)wid * 1024u;
    const int aoff = lds_byte(wr * 64 + fr, fq * 8), boff = lds_byte(wc * 32 + fr, fq * 8);
#define PG8_SA(b, h) (((b) * 2 + (h)) * HTB)
#define PG8_SB(b, h) ((4 + (b) * 2 + (h)) * HTB)
#define PG8_STAGE(bufoff, gbase, voff) do { _Pragma("unroll") for (int _i = 0; _i < 2; ++_i) \
        __builtin_amdgcn_global_load_lds((const unsigned*)((const char*)(gbase) + (voff)[_i]), (PG8_LAS unsigned*)(lds + (bufoff) + ldsw + _i * 8192), 16, 0, 0); } while (0)
#define PG8_LDA(dst, b, h) do { _Pragma("unroll") for (int m = 0; m < 4; ++m) _Pragma("unroll") for (int k = 0; k < 2; ++k) dst[m][k] = *(const PG8_LAS bf16x8*)(lds + PG8_SA(b, h) + aoff + m * 2048 + k * 1024); } while (0)
#define PG8_LDB(dst, b, h) do { _Pragma("unroll") for (int n = 0; n < 2; ++n) _Pragma("unroll") for (int k = 0; k < 2; ++k) dst[n][k] = *(const PG8_LAS bf16x8*)(lds + PG8_SB(b, h) + boff + n * 2048 + k * 1024); } while (0)
#define PG8_MMA(ai, bj, At, Bt) do { __builtin_amdgcn_s_setprio(1); _Pragma("unroll") for (int m = 0; m < 4; ++m) _Pragma("unroll") for (int n = 0; n < 2; ++n) _Pragma("unroll") for (int k = 0; k < 2; ++k) \
        acc[ai][bj][m][n] = __builtin_amdgcn_mfma_f32_16x16x32_bf16(Bt[n][k], At[m][k], acc[ai][bj][m][n], 0, 0, 0); __builtin_amdgcn_s_setprio(0); } while (0)
#define PG8_WAIT_V(n) asm volatile("s_waitcnt vmcnt(" #n ")" ::: "memory")
#define PG8_WAIT_L(n) asm volatile("s_waitcnt lgkmcnt(" #n ")" ::: "memory")
#define PG8_BAR __builtin_amdgcn_s_barrier()
#define PG8_SCHED __builtin_amdgcn_sched_barrier(0)
    Unit cur, nxt; int ui = 0;
    if (!S.next(0, cur)) return;
    f32x4 acc[2][2][4][2];
#pragma unroll
    for (int a = 0; a < 2; ++a)
#pragma unroll
        for (int b = 0; b < 2; ++b)
#pragma unroll
            for (int m = 0; m < 4; ++m)
#pragma unroll
                for (int n = 0; n < 2; ++n) acc[a][b][m][n] = (f32x4){0.f, 0.f, 0.f, 0.f};
    bf16x8 At[4][2], B0[2][2], B1[2][2];
    unsigned vA[2][2], vN[2][2];
    S.a_voff(cur, sR, sC, vA);
    const char* cA = S.a_base(cur);
    if constexpr (SP2) {
        PG8_STAGE(PG8_SB(0, 0), S.b_base(cur, 0, 0), voffB); PG8_STAGE(PG8_SB(0, 1), S.b_base(cur, 1, 0), voffB); PG8_STAGE(PG8_SA(0, 0), cA, vA[0]); PG8_STAGE(PG8_SA(0, 1), cA, vA[1]);
        if (wr == 1) PG8_BAR;
        PG8_WAIT_V(2); PG8_BAR;
        PG8_STAGE(PG8_SB(1, 0), S.b_base(cur, 0, 1), voffB); PG8_STAGE(PG8_SA(1, 0), cA + kstep, vA[0]); PG8_STAGE(PG8_SB(1, 1), S.b_base(cur, 1, 1), voffB);
        PG8_WAIT_V(6); PG8_BAR;
    } else {
        PG8_STAGE(PG8_SB(0, 0), S.b_base(cur, 0, 0), voffB); PG8_STAGE(PG8_SA(0, 0), cA, vA[0]); PG8_STAGE(PG8_SB(0, 1), S.b_base(cur, 1, 0), voffB); PG8_STAGE(PG8_SA(0, 1), cA, vA[1]);
        if (wr == 1) PG8_BAR;
        PG8_WAIT_V(4); PG8_BAR;
        PG8_STAGE(PG8_SB(1, 0), S.b_base(cur, 0, 1), voffB); PG8_STAGE(PG8_SA(1, 0), cA + kstep, vA[0]); PG8_STAGE(PG8_SB(1, 1), S.b_base(cur, 1, 1), voffB);
        PG8_WAIT_V(6); PG8_BAR;
    }
    for (;;) {
        const bool has_next = S.next(ui + 1, nxt);
        if (!has_next) nxt = cur;
        const char* nA = S.a_base(nxt);
        if (Sched::GATHER) { S.a_voff(nxt, sR, sC, vN); }
        else {
#pragma unroll
            for (int h = 0; h < 2; ++h)
#pragma unroll
                for (int i = 0; i < 2; ++i) vN[h][i] = vA[h][i]; }
        for (int t = 0; t < nt; t += 2) {
            const bool last = (t == nt - 2);
            const char* a1 = cA + (size_t)(t + 1) * kstep;
            const char* a2 = last ? nA : cA + (size_t)(t + 2) * kstep; const char* a3 = a2 + kstep;
            const Unit& bu = last ? nxt : cur; const int k2 = last ? 0 : t + 2, k3 = k2 + 1;
            const char* b20 = S.b_base(bu, 0, k2); const char* b21 = S.b_base(bu, 1, k2); const char* b30 = S.b_base(bu, 0, k3); const char* b31 = S.b_base(bu, 1, k3);
            unsigned v2[2][2];
#pragma unroll
            for (int h = 0; h < 2; ++h)
#pragma unroll
                for (int i = 0; i < 2; ++i) v2[h][i] = last ? vN[h][i] : vA[h][i];
            if constexpr (SP2) {
            PG8_LDB(B0, 0, 0); PG8_LDB(B1, 0, 1); PG8_SCHED; PG8_LDA(At, 0, 0); PG8_STAGE(PG8_SA(1, 1), a1, vA[1]);
            PG8_WAIT_V(8); PG8_WAIT_L(0); PG8_BAR; PG8_MMA(0, 0, At, B0); PG8_MMA(0, 1, At, B1); PG8_BAR; PG8_SCHED;
            PG8_LDA(At, 0, 1); PG8_STAGE(PG8_SB(0, 0), b20, voffB); PG8_STAGE(PG8_SB(0, 1), b21, voffB); PG8_STAGE(PG8_SA(0, 0), a2, v2[0]);
            PG8_WAIT_V(8); PG8_WAIT_L(0); PG8_BAR; PG8_MMA(1, 0, At, B0); PG8_MMA(1, 1, At, B1); PG8_BAR; PG8_SCHED;
            PG8_LDB(B0, 1, 0); PG8_LDB(B1, 1, 1); PG8_SCHED; PG8_LDA(At, 1, 0); PG8_STAGE(PG8_SA(0, 1), a2, v2[1]);
            PG8_WAIT_V(8); PG8_WAIT_L(0); PG8_BAR; PG8_MMA(0, 0, At, B0); PG8_MMA(0, 1, At, B1); PG8_BAR; PG8_SCHED;
            PG8_LDA(At, 1, 1); PG8_STAGE(PG8_SB(1, 0), b30, voffB); PG8_STAGE(PG8_SB(1, 1), b31, voffB); PG8_STAGE(PG8_SA(1, 0), a3, v2[0]);
            PG8_WAIT_V(8); PG8_WAIT_L(0); PG8_BAR; PG8_MMA(1, 0, At, B0); PG8_MMA(1, 1, At, B1); PG8_BAR; PG8_SCHED;
            } else {
            PG8_LDB(B0, 0, 0); PG8_SCHED; PG8_LDA(At, 0, 0); PG8_STAGE(PG8_SA(1, 1), a1, vA[1]);
            PG8_WAIT_L(8); PG8_BAR; PG8_WAIT_L(0); PG8_MMA(0, 0, At, B0); PG8_BAR; PG8_SCHED;
            PG8_LDB(B1, 0, 1); PG8_STAGE(PG8_SB(0, 0), b20, voffB);
            PG8_BAR; PG8_WAIT_L(0); PG8_MMA(0, 1, At, B1); PG8_BAR;
            PG8_LDA(At, 0, 1); PG8_STAGE(PG8_SA(0, 0), a2, v2[0]);
            PG8_BAR; PG8_WAIT_L(0); PG8_MMA(1, 0, At, B0); PG8_BAR; PG8_SCHED;
            PG8_STAGE(PG8_SB(0, 1), b21, voffB);
            PG8_WAIT_V(6); PG8_BAR; PG8_MMA(1, 1, At, B1); PG8_BAR;
            PG8_LDB(B0, 1, 0); PG8_SCHED; PG8_LDA(At, 1, 0); PG8_STAGE(PG8_SA(0, 1), a2, v2[1]);
            PG8_WAIT_L(8); PG8_BAR; PG8_WAIT_L(0); PG8_MMA(0, 0, At, B0); PG8_BAR; PG8_SCHED;
            PG8_LDB(B1, 1, 1); PG8_STAGE(PG8_SB(1, 0), b30, voffB);
            PG8_BAR; PG8_WAIT_L(0); PG8_MMA(0, 1, At, B1); PG8_BAR;
            PG8_LDA(At, 1, 1); PG8_STAGE(PG8_SA(1, 0), a3, v2[0]);
            PG8_BAR; PG8_WAIT_L(0); PG8_MMA(1, 0, At, B0); PG8_BAR; PG8_SCHED;
            PG8_STAGE(PG8_SB(1, 1), b31, voffB);
            PG8_WAIT_V(6); PG8_BAR; PG8_MMA(1, 1, At, B1); PG8_BAR;
            }
        }
        if constexpr (ALIGN_EPI) { if (wr == 0) PG8_BAR; }
        E(acc, cur, wr, wc, fr, fq);
        if (!has_next) break;
#pragma unroll
        for (int a = 0; a < 2; ++a)
#pragma unroll
            for (int b = 0; b < 2; ++b)
#pragma unroll
                for (int m = 0; m < 4; ++m)
#pragma unroll
                    for (int n = 0; n < 2; ++n) acc[a][b][m][n] = (f32x4){0.f, 0.f, 0.f, 0.f};
        cur = nxt; cA = nA; ++ui;
#pragma unroll
        for (int h = 0; h < 2; ++h)
#pragma unroll
            for (int i = 0; i < 2; ++i) vA[h][i] = vN[h][i];
        if constexpr (ALIGN_EPI) { if (wr == 1) PG8_BAR; }
    }
    PG8_WAIT_V(0);
    if constexpr (!ALIGN_EPI) { if (wr == 0) PG8_BAR; }
    PG8_BAR;
#undef PG8_SA
#undef PG8_SB
#undef PG8_STAGE
#undef PG8_LDA
#undef PG8_LDB
#undef PG8_MMA
#undef PG8_WAIT_V
#undef PG8_WAIT_L
#undef PG8_BAR
#undef PG8_SCHED
}
}

#define XB_TMO      128
#define XB_XCNT(j)  (256  + 64 * (j))
#define XB_XSUB(j)  (1280 + 64 * (j))
#define XB_XGEN(j)  (2304 + 64 * (j))
#define XB_TOP      3328
#define XB_TOPGEN   3392
#define XCD_BAR_WORDS 3456
#define XB_SPIN_CAP (1u << 18)
__device__ __forceinline__ unsigned xb_ld(unsigned* p)              { return __hip_atomic_load(p, __ATOMIC_RELAXED, __HIP_MEMORY_SCOPE_AGENT); }
__device__ __forceinline__ unsigned xb_add(unsigned* p, unsigned v) { return __hip_atomic_fetch_add(p, v, __ATOMIC_RELAXED, __HIP_MEMORY_SCOPE_AGENT); }
__device__ __forceinline__ unsigned xb_xcc_id() { return (unsigned)__builtin_amdgcn_s_getreg((3 << 11) | 20) & 0xFu; }
#define XB_SPIN(cond, bar) do { unsigned _sp = 0; while (cond) { __builtin_amdgcn_s_sleep(1); \
    if ((++_sp & 255u) == 0u) { if (xb_ld(&(bar)[XB_TMO])) break; if (_sp > XB_SPIN_CAP) { atomicAdd(&(bar)[XB_TMO], 1u); break; } } } } while (0)
struct XcdBarrier { unsigned* bar; unsigned x; volatile LAS unsigned* st; };
__device__ __forceinline__ XcdBarrier xcd_barrier_post(unsigned* bar, volatile LAS unsigned* st) {
    XcdBarrier b; b.bar = bar; b.x = xb_xcc_id(); b.st = st;
    if (threadIdx.x == 0) (void)xb_add(&bar[XB_XCNT(b.x)], 1u);
    return b;
}
__device__ __forceinline__ void xcd_barrier_complete(unsigned* bar, unsigned x, unsigned& nloc, unsigned& nx) {
    const unsigned G = gridDim.x * gridDim.y * gridDim.z;
    unsigned sum, cnt, mine, sp = 0u;
    for (;;) {
        sum = 0u; cnt = 0u; mine = 0u;
#pragma unroll
        for (unsigned j = 0; j < 16; ++j) { const unsigned c = xb_ld(&bar[XB_XCNT(j)]); sum += c; cnt += (c > 0u) ? 1u : 0u; mine = (j == x) ? c : mine; }
        if (sum == G) break;
        __builtin_amdgcn_s_sleep(1);
        if ((++sp & 255u) == 0u) { if (xb_ld(&bar[XB_TMO])) break; if (sp > XB_SPIN_CAP) { atomicAdd(&bar[XB_TMO], 1u); break; } }
    }
    nloc = mine > 0u ? mine : 1u; nx = cnt > 0u ? cnt : 1u;
}
__device__ __forceinline__ void xcd_barrier(const XcdBarrier& b) {
    asm volatile("s_waitcnt vmcnt(0)" ::: "memory");
    __syncthreads();
    if (threadIdx.x == 0) {
        unsigned* bar = b.bar;
        __builtin_amdgcn_s_waitcnt(0);
        unsigned nloc = b.st[0], nx = b.st[1];
        if (nloc == 0u) { xcd_barrier_complete(bar, b.x, nloc, nx); b.st[0] = nloc; b.st[1] = nx; }
        const unsigned old = xb_add(&bar[XB_XSUB(b.x)], 1u);
        const unsigned gen = old / nloc;
        if (old + 1u == (gen + 1u) * nloc) {
            __builtin_amdgcn_fence(__ATOMIC_RELEASE, "agent");
            asm volatile("s_waitcnt vmcnt(0)" ::: "memory");
            const unsigned og = xb_add(&bar[XB_TOP], 1u);
            const unsigned tg = og / nx;
            if (og + 1u == (tg + 1u) * nx) xb_add(&bar[XB_TOPGEN], 1u);
            else XB_SPIN(xb_ld(&bar[XB_TOPGEN]) == tg, bar);
            __builtin_amdgcn_fence(__ATOMIC_ACQUIRE, "agent");
            xb_add(&bar[XB_XGEN(b.x)], 1u);
            asm volatile("s_waitcnt vmcnt(0)" ::: "memory");
        } else {
            XB_SPIN(xb_ld(&bar[XB_XGEN(b.x)]) == gen, bar);
            __builtin_amdgcn_fence(__ATOMIC_ACQUIRE, "agent");
            asm volatile("s_waitcnt vmcnt(0)" ::: "memory");
        }
    }
    __syncthreads();
}

struct Frame {
    LAS unsigned char* lds;
    volatile LAS unsigned* MISC;
    gu32* ctl;
    int tid, lane, wave, vcu, G;
    unsigned char* ws; float* out;
    const float *x, *w_in, *w_out, *g_mix, *g_ffn, *g_fin, *g_att, *rel_bias, *dec_f, *dec_b, *rgw, *rgb, *rew, *reb, *w1, *w3, *w2;
    bf16 *WinT, *WoutT, *W1T, *W3T, *W2T, *XN, *PROJ, *MIX, *HID;
    float *COS, *SIN, *BIAS, *KV;
    bf16* ATTO; float* ATTL;
    ListEnt* LIST;
};

__device__ __forceinline__ void p0_transpose_item(const float* W, int K, int N, bf16* WT, int row_off, LAS float* scr, int item, int lane, const float* ksc, int klim, float csc) {
    const int nblk = N / 32, kb = item / nblk, nb = item % nblk, k0 = 64 * kb, n0 = 32 * nb;
#pragma unroll 8
    for (int i = 0; i < 32; ++i) { const int kk = 2 * i + (lane >> 5); const int k = k0 + kk; float s = csc; if (ksc && k < klim) s *= ksc[k];
        scr[kk * 33 + (lane & 31)] = W[(size_t)k * N + n0 + (lane & 31)] * s; }
    LDS_WAIT(); asm volatile("" ::: "memory");
    const int c = lane & 7;
#pragma unroll
    for (int j = 0; j < 4; ++j) { const int n = (lane >> 3) + 8 * j; const LAS float* s = scr + (8 * c) * 33 + n;
        v4u o; o.x = pk2(s[0 * 33], s[1 * 33]); o.y = pk2(s[2 * 33], s[3 * 33]); o.z = pk2(s[4 * 33], s[5 * 33]); o.w = pk2(s[6 * 33], s[7 * 33]);
        *(GAS v4u*)(WT + (size_t)(row_off + n0 + n) * K + k0 + 8 * c) = o; }
    LDS_WAIT(); asm volatile("" ::: "memory");
}
__device__ __forceinline__ int t5_bucket(int rel) {
    const int n = rel < 0 ? -rel : rel; const int off = rel > 0 ? 16 : 0;
    if (n < 8) return off + n;
    int large = 8 + (int)(logf((float)n / 8.0f) / logf(128.0f) * 8.0f);
    if (large > 15) large = 15;
    return off + large;
}
__device__ __forceinline__ void p0_prologue(Frame& F) {
    LAS float* scr = (LAS float*)(F.lds + RING_OFF + F.wave * 16384);
    const int gw = F.vcu * NWAVES + F.wave, NGW = F.G * NWAVES;
    constexpr int I_IN = (D / 64) * (PW / 32), I_OUT = (D / 64) * (D / 32), I_UP = (D / 64) * (FF / 32), I_DN = (FF / 64) * (D / 32);
    constexpr int NITEMS = I_IN + I_OUT + NE * (2 * I_UP + I_DN);
    for (int it = gw; it < NITEMS; it += NGW) {
        int r = it;
        if (r < I_IN) { const int n0 = 32 * (r % (PW / 32)); const float csc = (n0 < C_AK || (n0 >= C_RK && n0 < C_RV)) ? 0.125f : 1.0f;
            p0_transpose_item(F.w_in, D, PW, F.WinT, 0, scr, r, F.lane, F.g_mix, D, csc); continue; } r -= I_IN;
        if (r < I_OUT) { p0_transpose_item(F.w_out, D, D, F.WoutT, 0, scr, r, F.lane, F.g_att, 512, 1.0f); continue; } r -= I_OUT;
        const int e = r / (2 * I_UP + I_DN); r -= e * (2 * I_UP + I_DN);
        if (r < I_UP) { p0_transpose_item(F.w1 + (size_t)e * D * FF, D, FF, F.W1T + (size_t)e * FF * D, 0, scr, r, F.lane, F.g_ffn, D, 1.0f); continue; } r -= I_UP;
        if (r < I_UP) { p0_transpose_item(F.w3 + (size_t)e * D * FF, D, FF, F.W3T + (size_t)e * FF * D, 0, scr, r, F.lane, F.g_ffn, D, 1.0f); continue; } r -= I_UP;
        p0_transpose_item(F.w2 + (size_t)e * FF * D, FF, D, F.W2T + (size_t)e * D * FF, 0, scr, r, F.lane, nullptr, 0, 1.0f);
    }
    for (int m = gw; m < M; m += NGW) {
        const GAS f32x4* xr = (const GAS f32x4*)(F.x + (size_t)m * D) + F.lane;
        f32x4 v[4]; float s = 0.f;
#pragma unroll
        for (int j = 0; j < 4; ++j) { v[j] = xr[64 * j]; s += (v[j].x * v[j].x + v[j].y * v[j].y) + (v[j].z * v[j].z + v[j].w * v[j].w); }
        const float rstd = 1.f / sqrtf(wave_sum(s) * (1.f / D) + EPS);
        GAS unsigned long long* o8 = (GAS unsigned long long*)(F.XN + (size_t)m * D) + F.lane;
#pragma unroll
        for (int j = 0; j < 4; ++j) o8[64 * j] = (unsigned long long)pk2(v[j].x * rstd, v[j].y * rstd) | ((unsigned long long)pk2(v[j].z * rstd, v[j].w * rstd) << 32);
    }
    const int gt = F.vcu * 512 + F.tid, NGT = F.G * 512;
    for (int i = gt; i < SEQ * 32; i += NGT) {
        const int pos = i >> 5, fi = i & 31;
        const float inv = powf(10000.0f, -(float)fi / 32.0f);
        const float ang = (float)pos * inv;
        const double a = (double)ang; const double k = rint(a * 0.15915494309189535); const double rr = a - k * 6.283185307179586477;
        F.COS[i] = (float)cos(rr); F.SIN[i] = (float)sin(rr);
    }
    for (int i = gt; i < 3 * NH * 132; i += NGT) {
        const int dl = i % 132, h = (i / 132) % NH, br = i / (132 * NH); const int d = br == 0 ? 1 : (br == 1 ? 4 : 16);
        float v = 0.f; if (dl <= 128) v = F.rel_bias[t5_bucket((dl - 64) * d) * NH + h];
        F.BIAS[i] = v;
    }
}

__device__ __forceinline__ void rotary_inplace(Frame& F) {
    const long gt = (long)F.vcu * 512 + F.tid, NGT = (long)F.G * 512;
    const long total = (long)M * 2 * NH * 8;
    for (long u = gt; u < total; u += NGT) {
        const int g4 = (int)(u & 7), h = (int)((u >> 3) & 7), qk = (int)((u >> 6) & 1); const int tok = (int)(u >> 7);
        const int pos = tok & (SEQ - 1);
        bf16* base = F.PROJ + (size_t)tok * PW + (qk ? C_RK : C_RQ) + h * HD + 4 * g4;
        const v2u a = *(const v2u*)base, b = *(const v2u*)(base + 32);
        const f32x4 c = *(const f32x4*)(F.COS + pos * 32 + 4 * g4), s = *(const f32x4*)(F.SIN + pos * 32 + 4 * g4);
        const float t1[4] = {bf_lo(a.x), bf_hi(a.x), bf_lo(a.y), bf_hi(a.y)}, t2[4] = {bf_lo(b.x), bf_hi(b.x), bf_lo(b.y), bf_hi(b.y)};
        float o1[4], o2[4];
#pragma unroll
        for (int j = 0; j < 4; ++j) { o1[j] = t1[j] * c[j] - t2[j] * s[j]; o2[j] = t1[j] * s[j] + t2[j] * c[j]; }
        v2u wa, wb; wa.x = pk2(o1[0], o1[1]); wa.y = pk2(o1[2], o1[3]); wb.x = pk2(o2[0], o2[1]); wb.y = pk2(o2[2], o2[3]);
        *(v2u*)base = wa; *(v2u*)(base + 32) = wb;
    }
}
__device__ __forceinline__ void load_row64(const bf16* p, float (&v)[64]) {
#pragma unroll
    for (int c = 0; c < 8; ++c) { const v4u w = *(const v4u*)(p + 8 * c);
        v[8 * c + 0] = bf_lo(w.x); v[8 * c + 1] = bf_hi(w.x); v[8 * c + 2] = bf_lo(w.y); v[8 * c + 3] = bf_hi(w.y);
        v[8 * c + 4] = bf_lo(w.z); v[8 * c + 5] = bf_hi(w.z); v[8 * c + 6] = bf_lo(w.w); v[8 * c + 7] = bf_hi(w.w); }
}
__device__ __forceinline__ void attn_naive(Frame& F) {
    const long gt = (long)F.vcu * 512 + F.tid, NGT = (long)F.G * 512;
    const long total = 3L * NB * NH * SEQ;
    for (long u = gt; u < total; u += NGT) {
        const int p = (int)(u & (SEQ - 1)), h = (int)((u >> 11) & 7), b = (int)((u >> 14) & 7), br = (int)(u >> 17);
        const int sh = 2 * br, d = 1 << sh, r = p & (d - 1), a = p >> sh, L = SEQ >> sh;
        float q[64]; load_row64(F.PROJ + (size_t)(b * SEQ + p) * PW + C_AQ + h * HD, q);
        float acc[64];
#pragma unroll
        for (int i = 0; i < 64; ++i) acc[i] = 0.f;
        float mx = -1e30f, l = 0.f;
        const int j0 = a - 64 < 0 ? 0 : a - 64, j1 = a + 64 > L - 1 ? L - 1 : a + 64;
        const float* bias = F.BIAS + (br * NH + h) * 132 + 64;
        for (int j = j0; j <= j1; ++j) {
            const size_t row = (size_t)(b * SEQ + (j << sh) + r) * PW;
            float kv[64]; load_row64(F.PROJ + row + C_AK + h * HD, kv);
            float s = 0.f;
#pragma unroll
            for (int i = 0; i < 64; ++i) s += q[i] * kv[i];
            s += bias[j - a];
            const float mn = fmaxf(mx, s), sc = __expf(mx - mn), pp = __expf(s - mn);
            load_row64(F.PROJ + row + C_AV + h * HD, kv);
            l = l * sc + pp;
#pragma unroll
            for (int i = 0; i < 64; ++i) acc[i] = acc[i] * sc + pp * kv[i];
            mx = mn;
        }
        const float il = 1.f / l;
        bf16* o = F.ATTO + ((size_t)br * M + (size_t)(b * SEQ + p)) * 512 + h * HD;
#pragma unroll
        for (int c = 0; c < 8; ++c) { v4u w; w.x = pk2(acc[8 * c] * il, acc[8 * c + 1] * il); w.y = pk2(acc[8 * c + 2] * il, acc[8 * c + 3] * il);
            w.z = pk2(acc[8 * c + 4] * il, acc[8 * c + 5] * il); w.w = pk2(acc[8 * c + 6] * il, acc[8 * c + 7] * il); *(v4u*)(o + 8 * c) = w; }
        F.ATTL[((size_t)br * M + (size_t)(b * SEQ + p)) * NH + h] = mx + __logf(l);
    }
}
__device__ __forceinline__ void ret_naive(Frame& F) {
    const long gt = (long)F.vcu * 512 + F.tid, NGT = (long)F.G * 512;
    const long total = (long)NB * NH * SEQ;
    for (long u = gt; u < total; u += NGT) {
        const int n = (int)(u & (SEQ - 1)), h = (int)((u >> 11) & 7), b = (int)(u >> 14);
        const float lgf = -__expf(F.dec_f[h]) * 1.4426950408889634f, lgb = -__expf(F.dec_b[h]) * 1.4426950408889634f;
        float q[64]; load_row64(F.PROJ + (size_t)(b * SEQ + n) * PW + C_RQ + h * HD, q);
        float acc[64];
#pragma unroll
        for (int i = 0; i < 64; ++i) acc[i] = 0.f;
        for (int m = 0; m < SEQ; ++m) {
            const size_t row = (size_t)(b * SEQ + m) * PW;
            float kv[64]; load_row64(F.PROJ + row + C_RK + h * HD, kv);
            float s = 0.f;
#pragma unroll
            for (int i = 0; i < 64; ++i) s += q[i] * kv[i];
            const float dec = (m <= n) ? exp2f(lgf * (float)(n - m)) : exp2f(lgb * (float)(m - n));
            s *= dec;
            load_row64(F.PROJ + row + C_RV + h * HD, kv);
#pragma unroll
            for (int i = 0; i < 64; ++i) acc[i] += s * kv[i];
        }
        float ss = 0.f;
#pragma unroll
        for (int i = 0; i < 64; ++i) ss += acc[i] * acc[i];
        const float rs = 1.f / sqrtf(ss * (1.f / 64.f) + EPS);
        float g[64]; load_row64(F.PROJ + (size_t)(b * SEQ + n) * PW + C_RG + h * HD, g);
        bf16* o = F.MIX + (size_t)(b * SEQ + n) * D + 512 + h * HD;
        float y[64];
#pragma unroll
        for (int i = 0; i < 64; ++i) { const float gg = g[i]; y[i] = acc[i] * rs * (gg / (1.f + __expf(-gg))); }
#pragma unroll
        for (int c = 0; c < 8; ++c) { v4u w; w.x = pk2(y[8 * c], y[8 * c + 1]); w.y = pk2(y[8 * c + 2], y[8 * c + 3]); w.z = pk2(y[8 * c + 4], y[8 * c + 5]); w.w = pk2(y[8 * c + 6], y[8 * c + 7]); *(v4u*)(o + 8 * c) = w; }
    }
}
__device__ __forceinline__ void attn_combine(Frame& F) {
    const int gw = F.vcu * NWAVES + F.wave, NGW = F.G * NWAVES;
    for (int tok = gw; tok < M; tok += NGW) {
        const int h = F.lane >> 3;
        const float l0 = F.ATTL[((size_t)0 * M + tok) * NH + h], l1 = F.ATTL[((size_t)1 * M + tok) * NH + h], l2 = F.ATTL[((size_t)2 * M + tok) * NH + h];
        const float mx = fmaxf(l0, fmaxf(l1, l2)); const float e0 = __expf(l0 - mx), e1 = __expf(l1 - mx), e2 = __expf(l2 - mx); const float inv = 1.f / (e0 + e1 + e2);
        const float w0 = e0 * inv, w1 = e1 * inv, w2 = e2 * inv;
        const v4u a = *(const v4u*)(F.ATTO + ((size_t)0 * M + tok) * 512 + 8 * F.lane), b = *(const v4u*)(F.ATTO + ((size_t)1 * M + tok) * 512 + 8 * F.lane), c = *(const v4u*)(F.ATTO + ((size_t)2 * M + tok) * 512 + 8 * F.lane);
        float o[8];
        o[0] = w0 * bf_lo(a.x) + w1 * bf_lo(b.x) + w2 * bf_lo(c.x); o[1] = w0 * bf_hi(a.x) + w1 * bf_hi(b.x) + w2 * bf_hi(c.x);
        o[2] = w0 * bf_lo(a.y) + w1 * bf_lo(b.y) + w2 * bf_lo(c.y); o[3] = w0 * bf_hi(a.y) + w1 * bf_hi(b.y) + w2 * bf_hi(c.y);
        o[4] = w0 * bf_lo(a.z) + w1 * bf_lo(b.z) + w2 * bf_lo(c.z); o[5] = w0 * bf_hi(a.z) + w1 * bf_hi(b.z) + w2 * bf_hi(c.z);
        o[6] = w0 * bf_lo(a.w) + w1 * bf_lo(b.w) + w2 * bf_lo(c.w); o[7] = w0 * bf_hi(a.w) + w1 * bf_hi(b.w) + w2 * bf_hi(c.w);
        float ss = 0.f;
#pragma unroll
        for (int i = 0; i < 8; ++i) ss += o[i] * o[i];
        const float rs = 1.f / sqrtf(wave_sum(ss) * (1.f / 512.f) + EPS);
        v4u w; w.x = pk2(o[0] * rs, o[1] * rs); w.y = pk2(o[2] * rs, o[3] * rs); w.z = pk2(o[4] * rs, o[5] * rs); w.w = pk2(o[6] * rs, o[7] * rs);
        *(v4u*)(F.MIX + (size_t)tok * D + 8 * F.lane) = w;
    }
}
__device__ __forceinline__ void router(Frame& F) {
    LAS int* s_cls = (LAS int*)(F.lds + RT_OFF); LAS float* s_glo = (LAS float*)(F.lds + RT_OFF + 256); LAS float* s_ghi = (LAS float*)(F.lds + RT_OFF + 512);
    LAS int* s_base = (LAS int*)(F.lds + RT_OFF + 768);
    const float* h1 = F.out;
    for (int blk = F.vcu; blk < M / 64; blk += F.G) {
        for (int t = 0; t < 8; ++t) {
            const int tl = F.wave * 8 + t, tok = blk * 64 + tl;
            const GAS f32x4* hr = (const GAS f32x4*)(h1 + (size_t)tok * D) + F.lane;
            f32x4 v[4]; float s = 0.f;
#pragma unroll
            for (int j = 0; j < 4; ++j) { v[j] = hr[64 * j]; s += (v[j].x * v[j].x + v[j].y * v[j].y) + (v[j].z * v[j].z + v[j].w * v[j].w); }
            const float rstd = 1.f / sqrtf(wave_sum(s) * (1.f / D) + EPS);
            GAS unsigned long long* o8 = (GAS unsigned long long*)(F.XN + (size_t)tok * D) + F.lane;
            float gl[4] = {0.f, 0.f, 0.f, 0.f};
#pragma unroll
            for (int j = 0; j < 4; ++j) { const int k = 4 * F.lane + 256 * j; v[j] = v[j] * rstd;
                o8[64 * j] = (unsigned long long)pk2(v[j].x, v[j].y) | ((unsigned long long)pk2(v[j].z, v[j].w) << 32);
                const f32x4 gn = *(const f32x4*)(F.g_ffn + k); v[j] = v[j] * gn;
#pragma unroll
                for (int e = 0; e < 4; ++e) { const f32x4 wg = *(const f32x4*)(F.rgw + (size_t)(k + e) * 4);
                    gl[0] += v[j][e] * wg.x; gl[1] += v[j][e] * wg.y; gl[2] += v[j][e] * wg.z; gl[3] += v[j][e] * wg.w; } }
#pragma unroll
            for (int e = 0; e < 4; ++e) gl[e] = wave_sum(gl[e]) + F.rgb[e];
            int g = 0; float gm = gl[0];
#pragma unroll
            for (int e = 1; e < 4; ++e) if (gl[e] > gm) { gm = gl[e]; g = e; }
            const float pg = 1.f / (__expf(gl[0] - gm) + __expf(gl[1] - gm) + __expf(gl[2] - gm) + __expf(gl[3] - gm));
            float el[4] = {0.f, 0.f, 0.f, 0.f};
            const float* we = F.rew + (size_t)g * D * 4;
#pragma unroll
            for (int j = 0; j < 4; ++j) { const int k = 4 * F.lane + 256 * j;
#pragma unroll
                for (int e = 0; e < 4; ++e) { const f32x4 w = *(const f32x4*)(we + (size_t)(k + e) * 4);
                    el[0] += v[j][e] * w.x; el[1] += v[j][e] * w.y; el[2] += v[j][e] * w.z; el[3] += v[j][e] * w.w; } }
#pragma unroll
            for (int e = 0; e < 4; ++e) el[e] = wave_sum(el[e]) + F.reb[g * 4 + e];
            int i1 = 0; float v1 = el[0];
#pragma unroll
            for (int e = 1; e < 4; ++e) if (el[e] > v1) { v1 = el[e]; i1 = e; }
            int i2 = -1; float v2 = -3.0e38f;
#pragma unroll
            for (int e = 0; e < 4; ++e) if (e != i1 && el[e] > v2) { v2 = el[e]; i2 = e; }
            const float p2 = 1.f / (1.f + __expf(v1 - v2)), p1 = 1.f - p2;
            const int lo = i1 < i2 ? i1 : i2, hi = i1 < i2 ? i2 : i1;
            const float glo = pg * (i1 < i2 ? p1 : p2), ghi = pg * (i1 < i2 ? p2 : p1);
            const int pidx = lo == 0 ? hi - 1 : (lo == 1 ? 1 + hi : 5);
            if (F.lane == 0) { s_cls[tl] = g * 6 + pidx; s_glo[tl] = glo; s_ghi[tl] = ghi; }
        }
        LDS_WAIT(); __syncthreads();
        if (F.tid < NCLS) { int n = 0;
            for (int i = 0; i < 64; ++i) n += (s_cls[i] == F.tid) ? 1 : 0;
            int base = 0; if (n > 0) base = (int)__hip_atomic_fetch_add((unsigned*)(F.ctl + CW_CLS + 64 * F.tid), (unsigned)n, RLX_AGENT);
            s_base[F.tid] = base; }
        LDS_WAIT(); __syncthreads();
        if (F.tid < 64) { const int c = s_cls[F.tid]; int rank = 0;
            for (int i = 0; i < F.tid; ++i) rank += (s_cls[i] == c) ? 1 : 0;
            ListEnt e; e.tok = blk * 64 + F.tid; e.glo = s_glo[F.tid]; e.ghi = s_ghi[F.tid]; e.pad = 0;
            F.LIST[(size_t)c * LCAP + s_base[c] + rank] = e; }
        LDS_WAIT(); __syncthreads();
    }
}
__device__ __forceinline__ void cls_experts(int cls, int& elo, int& ehi) { const int g = cls / 6, p = cls % 6; const int lo = p < 3 ? 0 : (p < 5 ? 1 : 2), hi = p < 3 ? p + 1 : (p < 5 ? p - 1 : 3); elo = 4 * g + lo; ehi = 4 * g + hi; }
__device__ __forceinline__ void moe_tab_build(Frame& F) {
    LAS int* tab = (LAS int*)(F.lds + MOETAB_OFF);
    if (F.tid == 0) { int t = 0;
        for (int c = 0; c < NCLS; ++c) { const int n = (int)__hip_atomic_load((unsigned*)(F.ctl + CW_CLS + 64 * c), RLX_AGENT); tab[c] = n; tab[32 + c] = t; t += (n + 255) >> 8; }
        tab[32 + NCLS] = t; }
    LDS_WAIT(); __syncthreads();
}
struct MoeOrderBase {
    const LAS int* tab; int G, c, ncol, nunits;
    __device__ __forceinline__ bool decode(int i, pg8::Unit& u) const {
        const long L = (long)i * G + c; if (L >= nunits) return false;
        const int wgid = pg8::xcd_remap((int)L, nunits);
        const int rt = wgid / ncol; u.pm = rt; u.pn = wgid % ncol;
        int cls = 0;
        for (int k = 1; k < NCLS; ++k) if (rt >= tab[32 + k]) cls = k;
        u.x0 = cls; u.x1 = tab[cls] - (rt - tab[32 + cls]) * 256;
        return true;
    }
};
struct UpOrder : MoeOrderBase {
    static constexpr bool GATHER = true;
    const bf16* HN; const bf16* W1T; const bf16* W3T; const ListEnt* list;
    __device__ __forceinline__ bool next(int i, pg8::Unit& u) const { return decode(i, u); }
    __device__ __forceinline__ const char* a_base(const pg8::Unit&) const { return (const char*)HN; }
    __device__ __forceinline__ void a_voff(const pg8::Unit& u, const int (&R)[2], const int (&C)[2], unsigned (&v)[2][2]) const {
        const int slot0 = (u.pm - tab[32 + u.x0]) * 256;
#pragma unroll
        for (int h = 0; h < 2; ++h)
#pragma unroll
            for (int i = 0; i < 2; ++i) { const int r = h * 128 + R[i]; int tok = 0; if (r < u.x1) tok = list[(size_t)u.x0 * LCAP + slot0 + r].tok;
                v[h][i] = (unsigned)(tok * D + C[i]) * 2u; }
    }
    __device__ __forceinline__ const char* b_base(const pg8::Unit& u, int half, int kt) const {
        int elo, ehi; cls_experts(u.x0, elo, ehi); const int e = u.pn < 4 ? elo : ehi;
        const bf16* W = half ? W3T : W1T;
        return (const char*)W + ((size_t)(e * FF + (u.pn & 3) * 128) * D + (size_t)kt * 64) * 2;
    }
};
struct DownOrder : MoeOrderBase {
    static constexpr bool GATHER = false;
    const bf16* HID; const bf16* W2T;
    __device__ __forceinline__ bool next(int i, pg8::Unit& u) const { return decode(i, u); }
    __device__ __forceinline__ const char* a_base(const pg8::Unit& u) const { return (const char*)HID + (size_t)u.pm * 256 * D * 2; }
    __device__ __forceinline__ void a_voff(const pg8::Unit&, const int (&R)[2], const int (&C)[2], unsigned (&v)[2][2]) const {
#pragma unroll
        for (int h = 0; h < 2; ++h)
#pragma unroll
            for (int i = 0; i < 2; ++i) v[h][i] = (unsigned)((h * 128 + R[i]) * D + C[i]) * 2u;
    }
    __device__ __forceinline__ const char* b_base(const pg8::Unit& u, int half, int kt) const {
        int elo, ehi; cls_experts(u.x0, elo, ehi); const int e = kt < 8 ? elo : ehi;
        return (const char*)W2T + ((size_t)(e * D + u.pn * 256 + half * 128) * FF + (size_t)(kt & 7) * 64) * 2;
    }
};
struct EpiUp {
    static constexpr bool PERM = true;
    bf16* HID; const ListEnt* list; const LAS int* tab;
    __device__ __forceinline__ void operator()(const f32x4 (&acc)[2][2][4][2], const pg8::Unit& u, int wr, int wc, int fr, int fq) const {
        const int slot0 = (u.pm - tab[32 + u.x0]) * 256; const bool usehi = u.pn >= 4;
#pragma unroll
        for (int ai = 0; ai < 2; ++ai)
#pragma unroll
            for (int m = 0; m < 4; ++m) { const int r = ai * 128 + wr * 64 + m * 16 + fr;
                float gate = 0.f; if (r < u.x1) { const ListEnt* e = list + (size_t)u.x0 * LCAP + slot0 + r; gate = usehi ? e->ghi : e->glo; }
                const f32x4 a0 = acc[ai][0][m][0], a1 = acc[ai][0][m][1], b0 = acc[ai][1][m][0], b1 = acc[ai][1][m][1];
                float o[8];
#pragma unroll
                for (int j = 0; j < 4; ++j) { o[j] = a0[j] / (1.f + __expf(-a0[j])) * b0[j] * gate; o[4 + j] = a1[j] / (1.f + __expf(-a1[j])) * b1[j] * gate; }
                pg8::u32x4 w; w.x = pg8::cvt_pk_bf16(o[0], o[1]); w.y = pg8::cvt_pk_bf16(o[2], o[3]); w.z = pg8::cvt_pk_bf16(o[4], o[5]); w.w = pg8::cvt_pk_bf16(o[6], o[7]);
                *(pg8::u32x4*)(HID + (size_t)(u.pm * 256 + r) * D + u.pn * 128 + wc * 32 + 8 * fq) = w; }
    }
};
struct EpiDown {
    static constexpr bool PERM = false;
    float* out; const ListEnt* list; const LAS int* tab;
    __device__ __forceinline__ void operator()(const f32x4 (&acc)[2][2][4][2], const pg8::Unit& u, int wr, int wc, int fr, int fq) const {
        const int slot0 = (u.pm - tab[32 + u.x0]) * 256; const int col0 = u.pn * 256 + wc * 32 + 4 * fq;
#pragma unroll
        for (int ai = 0; ai < 2; ++ai)
#pragma unroll
            for (int m = 0; m < 4; ++m) { const int r = ai * 128 + wr * 64 + m * 16 + fr;
                if (r < u.x1) { const int tok = list[(size_t)u.x0 * LCAP + slot0 + r].tok; float* rowp = out + (size_t)tok * D + col0;
#pragma unroll
                    for (int bj = 0; bj < 2; ++bj)
#pragma unroll
                        for (int n = 0; n < 2; ++n) { const f32x4 h = *(const f32x4*)(rowp + bj * 128 + n * 16); *(f32x4*)(rowp + bj * 128 + n * 16) = h + acc[ai][bj][m][n]; } }
                asm volatile("" ::: "memory"); }
    }
};
__device__ __forceinline__ void final_norm(Frame& F) {
    const int gw = F.vcu * NWAVES + F.wave, NGW = F.G * NWAVES;
    for (int m = gw; m < M; m += NGW) {
        GAS f32x4* xr = (GAS f32x4*)(F.out + (size_t)m * D) + F.lane;
        f32x4 v[4]; float s = 0.f;
#pragma unroll
        for (int j = 0; j < 4; ++j) { v[j] = xr[64 * j]; s += (v[j].x * v[j].x + v[j].y * v[j].y) + (v[j].z * v[j].z + v[j].w * v[j].w); }
        const float rstd = 1.f / sqrtf(wave_sum(s) * (1.f / D) + EPS);
#pragma unroll
        for (int j = 0; j < 4; ++j) { const f32x4 g = *(const f32x4*)(F.g_fin + 4 * F.lane + 256 * j); xr[64 * j] = v[j] * rstd * g; }
    }
}

constexpr int NPHASE = 9;
struct Args { const float* in[17]; float* out; unsigned char* ws; int ph_lo, ph_hi; };
__global__ void __launch_bounds__(NWAVES * 64, 2) hybrid_fwd(Args args) {
    extern __shared__ __attribute__((aligned(16))) unsigned char lds[];
    Frame F;
    F.lds = (LAS unsigned char*)lds;
    F.MISC = (volatile LAS unsigned*)(F.lds + MISC_OFF);
    F.tid = threadIdx.x; F.lane = F.tid & 63; F.wave = __builtin_amdgcn_readfirstlane(F.tid >> 6);
    F.G = gridDim.x; { const int bx = blockIdx.x; F.vcu = (F.G % 8 == 0) ? (bx % 8) * (F.G / 8) + bx / 8 : bx; }
    unsigned char* ws = args.ws; F.ws = ws; F.out = args.out;
    F.ctl = (gu32*)(ws + WS_CTL);
    F.x = args.in[0]; F.w_in = args.in[1]; F.w_out = args.in[2]; F.g_mix = args.in[3]; F.g_ffn = args.in[4]; F.g_fin = args.in[5]; F.g_att = args.in[6]; F.rel_bias = args.in[7];
    F.dec_f = args.in[8]; F.dec_b = args.in[9]; F.rgw = args.in[10]; F.rgb = args.in[11]; F.rew = args.in[12]; F.reb = args.in[13]; F.w1 = args.in[14]; F.w3 = args.in[15]; F.w2 = args.in[16];
    F.WinT = (bf16*)(ws + WS_WIN); F.WoutT = (bf16*)(ws + WS_WOUT); F.W1T = (bf16*)(ws + WS_W1); F.W3T = (bf16*)(ws + WS_W3); F.W2T = (bf16*)(ws + WS_W2);
    F.XN = (bf16*)(ws + WS_XN); F.PROJ = (bf16*)(ws + WS_PROJ); F.MIX = (bf16*)(ws + WS_MIX); F.HID = (bf16*)(ws + WS_PROJ);
    F.COS = (float*)(ws + WS_COS); F.SIN = (float*)(ws + WS_SIN); F.BIAS = (float*)(ws + WS_BIAS); F.KV = (float*)(ws + WS_XN);
    F.ATTO = (bf16*)((unsigned char*)args.out + DO_ATTO); F.ATTL = (float*)((unsigned char*)args.out + DO_ATTL);
    F.LIST = (ListEnt*)(ws + WS_LIST);
    for (int u = F.tid; u < (LDS_BYTES - LDSCTL_OFF) / 4; u += NWAVES * 64) ((LAS unsigned*)(F.lds + LDSCTL_OFF))[u] = 0u;
    __syncthreads();
#if MK_PER_PHASE
#define GRID_BAR() do { } while (0)
#else
    XcdBarrier bar = xcd_barrier_post((unsigned*)(F.ctl + CW_BAR), F.MISC + 8);
#define GRID_BAR() xcd_barrier(bar)
#endif
    const int lo = args.ph_lo, hi = args.ph_hi;
#define IN(k) (lo <= (k) && (k) < hi)
#define BOTH(k) (IN(k) && IN((k) + 1))

    if (IN(0)) { p0_prologue(F); if (BOTH(0)) GRID_BAR(); }
    if (IN(1)) {
        pg8::DenseOrder S; S.init(F.XN, F.WinT, M, PW, D, D, F.G, (int)blockIdx.x);
        pg8::EpiBf16 E{F.PROJ, PW};
        pg8::gemm_phase<pg8::EpiBf16, pg8::DenseOrder, true, true>(F.lds + RING_OFF, S, E, D, D);
        if (BOTH(1)) GRID_BAR();
    }
    if (IN(2)) { rotary_inplace(F); attn_naive(F); if (BOTH(2)) GRID_BAR(); }
    if (IN(3)) { ret_naive(F); attn_combine(F); if (BOTH(3)) GRID_BAR(); }
    if (IN(4)) {
        pg8::DenseOrder S; S.init(F.MIX, F.WoutT, M, D, D, D, F.G, (int)blockIdx.x);
        pg8::EpiResF32 E{F.x, F.out, D};
        pg8::gemm_phase<pg8::EpiResF32, pg8::DenseOrder, true, true>(F.lds + RING_OFF, S, E, D, D);
        if (BOTH(4)) GRID_BAR();
    }
    if (IN(5)) { router(F); if (BOTH(5)) GRID_BAR(); }
    if (IN(6)) {
        moe_tab_build(F);
        const LAS int* tab = (const LAS int*)(F.lds + MOETAB_OFF);
        UpOrder S; S.tab = tab; S.G = F.G; S.c = (int)blockIdx.x; S.ncol = 8; S.nunits = tab[32 + NCLS] * 8; S.HN = F.XN; S.W1T = F.W1T; S.W3T = F.W3T; S.list = F.LIST;
        EpiUp E{F.HID, F.LIST, tab};
        pg8::gemm_phase<EpiUp, UpOrder, true, true>(F.lds + RING_OFF, S, E, D, D);
        if (BOTH(6)) GRID_BAR();
    }
    if (IN(7)) {
        moe_tab_build(F);
        const LAS int* tab = (const LAS int*)(F.lds + MOETAB_OFF);
        DownOrder S; S.tab = tab; S.G = F.G; S.c = (int)blockIdx.x; S.ncol = 4; S.nunits = tab[32 + NCLS] * 4; S.HID = F.HID; S.W2T = F.W2T;
        EpiDown E{F.out, F.LIST, tab};
        pg8::gemm_phase<EpiDown, DownOrder, true, true>(F.lds + RING_OFF, S, E, FF, D);
        if (BOTH(7)) GRID_BAR();
    }
    if (IN(8)) { final_norm(F); }
#undef IN
#undef BOTH
}

extern "C" void kernel_launch(void* const* d_in, const int* in_sizes, int n_in, void* d_out, int out_size, void* d_ws, size_t ws_size, hipStream_t stream) {
    static int grid = 0;
    if (grid == 0) {
        if (n_in != 17 || in_sizes[0] != M * D || out_size != M * D || ws_size < WS_END) { fprintf(stderr, "kernel_launch: unexpected shapes (n_in %d, in0 %d, out %d, ws %zu)\n", n_in, n_in > 0 ? in_sizes[0] : -1, out_size, ws_size); grid = -1; return; }
        int dev = 0, cus = 0, per_cu = 0;
        if (hipGetDevice(&dev) != hipSuccess || hipDeviceGetAttribute(&cus, hipDeviceAttributeMultiprocessorCount, dev) != hipSuccess) { grid = -1; return; }
        if (hipFuncSetAttribute((const void*)hybrid_fwd, hipFuncAttributeMaxDynamicSharedMemorySize, LDS_BYTES) != hipSuccess) { fprintf(stderr, "kernel_launch: hipFuncSetAttribute failed\n"); grid = -1; return; }
        if (hipOccupancyMaxActiveBlocksPerMultiprocessor(&per_cu, (const void*)hybrid_fwd, NWAVES * 64, LDS_BYTES) != hipSuccess || per_cu < 1)
            fprintf(stderr, "kernel_launch: note: occupancy query reports %d workgroups per CU\n", per_cu);
        (void)hipGetLastError();
        grid = cus;
    }
    if (grid < 0) return;
    if (hipMemsetAsync((char*)d_ws + WS_CTL, 0, CTL_ZERO_BYTES, stream) != hipSuccess) return;
    Args a{};
    for (int i = 0; i < 17; ++i) a.in[i] = (const float*)d_in[i];
    a.out = (float*)d_out; a.ws = (unsigned char*)d_ws;
#if MK_PER_PHASE
    for (int p = 0; p < NPHASE; ++p) { a.ph_lo = p; a.ph_hi = p + 1; hipLaunchKernelGGL(hybrid_fwd, dim3(grid), dim3(NWAVES * 64), LDS_BYTES, stream, a); }
#else
    a.ph_lo = 0; a.ph_hi = NPHASE; hipLaunchKernelGGL(hybrid_fwd, dim3(grid), dim3(NWAVES * 64), LDS_BYTES, stream, a);
#endif
}
```

```cpp
#include <hip/hip_runtime.h>
#include <cstdio>
#include <cstdint>

#ifndef MK_PER_PHASE
#define MK_PER_PHASE 0
#endif

#define GAS __attribute__((address_space(1)))
#define LAS __attribute__((address_space(3)))
typedef unsigned short bf16;
typedef unsigned v4u __attribute__((ext_vector_type(4)));
typedef unsigned v2u __attribute__((ext_vector_type(2)));
typedef float f32x4 __attribute__((ext_vector_type(4)));
typedef float f32x2 __attribute__((ext_vector_type(2)));
typedef short bf16x8 __attribute__((ext_vector_type(8)));
typedef GAS unsigned gu32;
#define RLX_AGENT __ATOMIC_RELAXED, __HIP_MEMORY_SCOPE_AGENT
#define LDS_WAIT() asm volatile("s_waitcnt lgkmcnt(0)" ::: "memory")
#define VM_WAIT() asm volatile("s_waitcnt vmcnt(0)" ::: "memory")

constexpr int NB = 8, SEQ = 2048, D = 1024, M = NB * SEQ, PW = 3584, NH = 8, HD = 64;
constexpr int C_AQ = 0, C_AK = 512, C_AV = 1024, C_RQ = 1536, C_RK = 2048, C_RV = 2560, C_RG = 3072;
constexpr int NE = 16, FF = 512, NCLS = 24, LCAP = 16384;
constexpr float EPS = 1e-6f;
constexpr int RC = 128, NCH = SEQ / RC;

constexpr size_t MiB = 1u << 20;
constexpr size_t WS_CTL = 0, CTL_ZERO_BYTES = 1 * MiB;
constexpr size_t WS_COS = 1 * MiB, WS_SIN = WS_COS + 256 * 1024, WS_BIAS = WS_SIN + 256 * 1024;
constexpr size_t WS_WIN = 4 * MiB, WS_WOUT = 11 * MiB, WS_W1 = 13 * MiB, WS_W3 = 29 * MiB, WS_W2 = 45 * MiB;
constexpr size_t WS_XN = 61 * MiB;
constexpr size_t WS_PROJ = 93 * MiB;
constexpr size_t WS_MIX = 205 * MiB;
constexpr size_t WS_LIST = 237 * MiB;
constexpr size_t WS_END = 243 * MiB;
constexpr size_t DO_ATTO = 0, DO_ATTL = 48 * MiB;
constexpr int CW_TMO = 0, CW_CODE = 1, CW_BAR = 4096, CW_CLS = 16384;

constexpr int RING_OFF = 0, RING_BYTES = 131072;
constexpr int LDSCTL_OFF = RING_BYTES, MISC_OFF = LDSCTL_OFF + 320;
constexpr int MOETAB_OFF = LDSCTL_OFF + 1024;
constexpr int RT_OFF = LDSCTL_OFF + 2048;
constexpr int LDS_BYTES = 147456;
constexpr int NWAVES = 8;

struct ListEnt { int tok; float glo, ghi; int pad; };

__device__ __forceinline__ unsigned f2bf(float f) { unsigned u = __builtin_bit_cast(unsigned, f); return (u + 0x7fffu + ((u >> 16) & 1u)) >> 16; }
__device__ __forceinline__ unsigned pk2(float lo, float hi) { return f2bf(lo) | (f2bf(hi) << 16); }
__device__ __forceinline__ float bf_lo(unsigned w) { return __builtin_bit_cast(float, w << 16); }
__device__ __forceinline__ float bf_hi(unsigned w) { return __builtin_bit_cast(float, w & 0xffff0000u); }
__device__ __forceinline__ float wave_sum(float v) {
#pragma unroll
    for (int o = 1; o < 64; o <<= 1) v += __shfl_xor(v, o);
    return v;
}

namespace pg8 {
#define PG8_LAS __attribute__((address_space(3)))
typedef unsigned short bf16_t;
typedef unsigned u32x4 __attribute__((ext_vector_type(4)));
constexpr int BM = 256, BK = 64, HALF = 128, HTB = HALF * BK * 2, STAGE_BYTES = 8 * HTB, NXCD = 8, WGM = 8;

__host__ __device__ __forceinline__ int lds_byte(int r, int c) { const int st = (r >> 4) * 2 + (c >> 5), rr = r & 15, cc = c & 31, ob = rr * 64 + cc * 2; return st * 1024 + (ob ^ (((ob >> 9) & 1) << 5)); }
__host__ __device__ __forceinline__ void stage_rc(int b, int& R, int& C) { const int st = b / 1024, sb = b % 1024, swz = sb ^ (((sb >> 9) & 1) << 5); R = (st >> 1) * 16 + swz / 64; C = (st & 1) * 32 + (swz % 64) / 2; }
__host__ __device__ __forceinline__ int perm32(int rho) { const int n = rho >> 4, i = rho & 15; return 8 * (i >> 2) + 4 * n + (i & 3); }

struct Unit { int pm, pn, x0, x1; };

__device__ __forceinline__ int xcd_remap(int L, int nwg) { const int q = nwg / NXCD, r = nwg % NXCD, xcd = L % NXCD, off = L / NXCD; return (xcd < r ? xcd * (q + 1) : r * (q + 1) + (xcd - r) * q) + off; }

struct DenseOrder {
    static constexpr bool GATHER = false;
    const bf16_t* A; const bf16_t* Bt; int ldA, ldB; int nM, nN, nwg, G, c;
    __device__ void init(const bf16_t* A_, const bf16_t* Bt_, int M_, int N_, int ldA_, int ldB_, int G_, int c_) { A = A_; Bt = Bt_; ldA = ldA_; ldB = ldB_; nM = M_ / BM; nN = N_ / BM; nwg = nM * nN; G = G_; c = c_; }
    __device__ __forceinline__ bool next(int i, Unit& u) const {
        const long L = (long)i * G + c; if (L >= nwg) return false;
        const int wgid = xcd_remap((int)L, nwg);
        const int nig = WGM * nN, gid = wgid / nig, fm = gid * WGM, gsz = (nM - fm) < WGM ? (nM - fm) : WGM;
        u.pm = fm + ((wgid % nig) % gsz); u.pn = (wgid % nig) / gsz; u.x0 = 0; u.x1 = 0; return true;
    }
    __device__ __forceinline__ const char* a_base(const Unit& u) const { return (const char*)A + (size_t)u.pm * BM * ldA * 2; }
    __device__ __forceinline__ void a_voff(const Unit&, const int (&R)[2], const int (&C)[2], unsigned (&v)[2][2]) const {
#pragma unroll
        for (int h = 0; h < 2; ++h)
#pragma unroll
            for (int i = 0; i < 2; ++i) v[h][i] = (unsigned)((h * HALF + R[i]) * ldA + C[i]) * 2u;
    }
    __device__ __forceinline__ const char* b_base(const Unit& u, int half, int kt) const { return (const char*)Bt + ((size_t)(u.pn * BM + half * HALF) * ldB + (size_t)kt * BK) * 2; }
};

__device__ __forceinline__ unsigned cvt_pk_bf16(float lo, float hi) { unsigned r; asm volatile("v_cvt_pk_bf16_f32 %0, %1, %2" : "=v"(r) : "v"(lo), "v"(hi)); return r; }

struct EpiBf16 {
    static constexpr bool PERM = true;
    bf16_t* O; int ldc;
    __device__ __forceinline__ void operator()(const f32x4 (&acc)[2][2][4][2], const Unit& u, int wr, int wc, int fr, int fq) const {
        const int row0 = u.pm * BM + wr * 64 + fr; const int col0 = u.pn * BM + wc * 32 + 8 * fq;
#pragma unroll
        for (int ai = 0; ai < 2; ++ai)
#pragma unroll
            for (int m = 0; m < 4; ++m) { bf16_t* rowp = O + (size_t)(row0 + ai * HALF + m * 16) * ldc + col0;
#pragma unroll
                for (int bj = 0; bj < 2; ++bj) { const f32x4 v0 = acc[ai][bj][m][0], v1 = acc[ai][bj][m][1];
                    u32x4 w; w.x = cvt_pk_bf16(v0[0], v0[1]); w.y = cvt_pk_bf16(v0[2], v0[3]); w.z = cvt_pk_bf16(v1[0], v1[1]); w.w = cvt_pk_bf16(v1[2], v1[3]);
                    *(u32x4*)(rowp + bj * HALF) = w; } }
    }
};
struct EpiResF32 {
    static constexpr bool PERM = false;
    const float* res; float* out; int ldc;
    __device__ __forceinline__ void operator()(const f32x4 (&acc)[2][2][4][2], const Unit& u, int wr, int wc, int fr, int fq) const {
        const int row0 = u.pm * BM + wr * 64 + fr, col0 = u.pn * BM + wc * 32 + 4 * fq;
#pragma unroll
        for (int ai = 0; ai < 2; ++ai)
#pragma unroll
            for (int m = 0; m < 4; ++m) { const size_t off = (size_t)(row0 + ai * HALF + m * 16) * ldc + col0;
#pragma unroll
                for (int bj = 0; bj < 2; ++bj)
#pragma unroll
                    for (int n = 0; n < 2; ++n) { const f32x4 r = *(const f32x4*)(res + off + bj * HALF + n * 16); *(f32x4*)(out + off + bj * HALF + n * 16) = r + acc[ai][bj][m][n]; }
                asm volatile("" ::: "memory"); }
    }
};

template <class Epi, class Sched, bool ALIGN_EPI, bool SP2>
__device__ __forceinline__ void gemm_phase(PG8_LAS unsigned char* lds, const Sched& S, const Epi& E, const int ldB, const int K) {
    const int tid = threadIdx.x, wid = __builtin_amdgcn_readfirstlane(tid >> 6), lane = tid & 63, wr = wid >> 2, wc = wid & 3, fr = lane & 15, fq = lane >> 4;
    const int nt = K / BK;
    int sR[2], sC[2]; unsigned voffB[2];
#pragma unroll
    for (int i = 0; i < 2; ++i) { stage_rc(tid * 16 + i * 8192, sR[i], sC[i]); const int Rb = Epi::PERM ? ((sR[i] & ~31) + perm32(sR[i] & 31)) : sR[i];
        voffB[i] = (unsigned)(Rb * ldB + sC[i]) * 2u; }
    const size_t kstep = (size_t)(BK * 2);
    const unsigned ldsw = (unsigned)wid * 1024u;
    const int aoff = lds_byte(wr * 64 + fr, fq * 8), boff = lds_byte(wc * 32 + fr, fq * 8);
#define PG8_SA(b, h) (((b) * 2 + (h)) * HTB)
#define PG8_SB(b, h) ((4 + (b) * 2 + (h)) * HTB)
#define PG8_STAGE(bufoff, gbase, voff) do { _Pragma("unroll") for (int _i = 0; _i < 2; ++_i) \
        __builtin_amdgcn_global_load_lds((const unsigned*)((const char*)(gbase) + (voff)[_i]), (PG8_LAS unsigned*)(lds + (bufoff) + ldsw + _i * 8192), 16, 0, 0); } while (0)
#define PG8_LDA(dst, b, h) do { _Pragma("unroll") for (int m = 0; m < 4; ++m) _Pragma("unroll") for (int k = 0; k < 2; ++k) dst[m][k] = *(const PG8_LAS bf16x8*)(lds + PG8_SA(b, h) + aoff + m * 2048 + k * 1024); } while (0)
#define PG8_LDB(dst, b, h) do { _Pragma("unroll") for (int n = 0; n < 2; ++n) _Pragma("unroll") for (int k = 0; k < 2; ++k) dst[n][k] = *(const PG8_LAS bf16x8*)(lds + PG8_SB(b, h) + boff + n * 2048 + k * 1024); } while (0)
#define PG8_MMA(ai, bj, At, Bt) do { __builtin_amdgcn_s_setprio(1); _Pragma("unroll") for (int m = 0; m < 4; ++m) _Pragma("unroll") for (int n = 0; n < 2; ++n) _Pragma("unroll") for (int k = 0; k < 2; ++k) \
        acc[ai][bj][m][n] = __builtin_amdgcn_mfma_f32_16x16x32_bf16(Bt[n][k], At[m][k], acc[ai][bj][m][n], 0, 0, 0); __builtin_amdgcn_s_setprio(0); } while (0)
#define PG8_WAIT_V(n) asm volatile("s_waitcnt vmcnt(" #n ")" ::: "memory")
#define PG8_WAIT_L(n) asm volatile("s_waitcnt lgkmcnt(" #n ")" ::: "memory")
#define PG8_BAR __builtin_amdgcn_s_barrier()
#define PG8_SCHED __builtin_amdgcn_sched_barrier(0)
    Unit cur, nxt; int ui = 0;
    if (!S.next(0, cur)) return;
    f32x4 acc[2][2][4][2];
#pragma unroll
    for (int a = 0; a < 2; ++a)
#pragma unroll
        for (int b = 0; b < 2; ++b)
#pragma unroll
            for (int m = 0; m < 4; ++m)
#pragma unroll
                for (int n = 0; n < 2; ++n) acc[a][b][m][n] = (f32x4){0.f, 0.f, 0.f, 0.f};
    bf16x8 At[4][2], B0[2][2], B1[2][2];
    unsigned vA[2][2], vN[2][2];
    S.a_voff(cur, sR, sC, vA);
    const char* cA = S.a_base(cur);
    if constexpr (SP2) {
        PG8_STAGE(PG8_SB(0, 0), S.b_base(cur, 0, 0), voffB); PG8_STAGE(PG8_SB(0, 1), S.b_base(cur, 1, 0), voffB); PG8_STAGE(PG8_SA(0, 0), cA, vA[0]); PG8_STAGE(PG8_SA(0, 1), cA, vA[1]);
        if (wr == 1) PG8_BAR;
        PG8_WAIT_V(2); PG8_BAR;
        PG8_STAGE(PG8_SB(1, 0), S.b_base(cur, 0, 1), voffB); PG8_STAGE(PG8_SA(1, 0), cA + kstep, vA[0]); PG8_STAGE(PG8_SB(1, 1), S.b_base(cur, 1, 1), voffB);
        PG8_WAIT_V(6); PG8_BAR;
    } else {
        PG8_STAGE(PG8_SB(0, 0), S.b_base(cur, 0, 0), voffB); PG8_STAGE(PG8_SA(0, 0), cA, vA[0]); PG8_STAGE(PG8_SB(0, 1), S.b_base(cur, 1, 0), voffB); PG8_STAGE(PG8_SA(0, 1), cA, vA[1]);
        if (wr == 1) PG8_BAR;
        PG8_WAIT_V(4); PG8_BAR;
        PG8_STAGE(PG8_SB(1, 0), S.b_base(cur, 0, 1), voffB); PG8_STAGE(PG8_SA(1, 0), cA + kstep, vA[0]); PG8_STAGE(PG8_SB(1, 1), S.b_base(cur, 1, 1), voffB);
        PG8_WAIT_V(6); PG8_BAR;
    }
    for (;;) {
        const bool has_next = S.next(ui + 1, nxt);
        if (!has_next) nxt = cur;
        const char* nA = S.a_base(nxt);
        if (Sched::GATHER) { S.a_voff(nxt, sR, sC, vN); }
        else {
#pragma unroll
            for (int h = 0; h < 2; ++h)
#pragma unroll
                for (int i = 0; i < 2; ++i) vN[h][i] = vA[h][i]; }
        for (int t = 0; t < nt; t += 2) {
            const bool last = (t == nt - 2);
            const char* a1 = cA + (size_t)(t + 1) * kstep;
            const char* a2 = last ? nA : cA + (size_t)(t + 2) * kstep; const char* a3 = a2 + kstep;
            const Unit& bu = last ? nxt : cur; const int k2 = last ? 0 : t + 2, k3 = k2 + 1;
            const char* b20 = S.b_base(bu, 0, k2); const char* b21 = S.b_base(bu, 1, k2); const char* b30 = S.b_base(bu, 0, k3); const char* b31 = S.b_base(bu, 1, k3);
            unsigned v2[2][2];
#pragma unroll
            for (int h = 0; h < 2; ++h)
#pragma unroll
                for (int i = 0; i < 2; ++i) v2[h][i] = last ? vN[h][i] : vA[h][i];
            if constexpr (SP2) {
            PG8_LDB(B0, 0, 0); PG8_LDB(B1, 0, 1); PG8_SCHED; PG8_LDA(At, 0, 0); PG8_STAGE(PG8_SA(1, 1), a1, vA[1]);
            PG8_WAIT_V(8); PG8_WAIT_L(0); PG8_BAR; PG8_MMA(0, 0, At, B0); PG8_MMA(0, 1, At, B1); PG8_BAR; PG8_SCHED;
            PG8_LDA(At, 0, 1); PG8_STAGE(PG8_SB(0, 0), b20, voffB); PG8_STAGE(PG8_SB(0, 1), b21, voffB); PG8_STAGE(PG8_SA(0, 0), a2, v2[0]);
            PG8_WAIT_V(8); PG8_WAIT_L(0); PG8_BAR; PG8_MMA(1, 0, At, B0); PG8_MMA(1, 1, At, B1); PG8_BAR; PG8_SCHED;
            PG8_LDB(B0, 1, 0); PG8_LDB(B1, 1, 1); PG8_SCHED; PG8_LDA(At, 1, 0); PG8_STAGE(PG8_SA(0, 1), a2, v2[1]);
            PG8_WAIT_V(8); PG8_WAIT_L(0); PG8_BAR; PG8_MMA(0, 0, At, B0); PG8_MMA(0, 1, At, B1); PG8_BAR; PG8_SCHED;
            PG8_LDA(At, 1, 1); PG8_STAGE(PG8_SB(1, 0), b30, voffB); PG8_STAGE(PG8_SB(1, 1), b31, voffB); PG8_STAGE(PG8_SA(1, 0), a3, v2[0]);
            PG8_WAIT_V(8); PG8_WAIT_L(0); PG8_BAR; PG8_MMA(1, 0, At, B0); PG8_MMA(1, 1, At, B1); PG8_BAR; PG8_SCHED;
            } else {
            PG8_LDB(B0, 0, 0); PG8_SCHED; PG8_LDA(At, 0, 0); PG8_STAGE(PG8_SA(1, 1), a1, vA[1]);
            PG8_WAIT_L(8); PG8_BAR; PG8_WAIT_L(0); PG8_MMA(0, 0, At, B0); PG8_BAR; PG8_SCHED;
            PG8_LDB(B1, 0, 1); PG8_STAGE(PG8_SB(0, 0), b20, voffB);
            PG8_BAR; PG8_WAIT_L(0); PG8_MMA(0, 1, At, B1); PG8_BAR;
            PG8_LDA(At, 0, 1); PG8_STAGE(PG8_SA(0, 0), a2, v2[0]);
            PG8_BAR; PG8_WAIT_L(0); PG8_MMA(1, 0, At, B0); PG8_BAR; PG8_SCHED;
            PG8_STAGE(PG8_SB(0, 1), b21, voffB);
            PG8_WAIT_V(6); PG8_BAR; PG8_MMA(1, 1, At, B1); PG8_BAR;
            PG8_LDB(B0, 1, 0); PG8_SCHED; PG8_LDA(At, 1, 0); PG8_STAGE(PG8_SA(0, 1), a2, v2[1]);
            PG8_WAIT_L(8); PG8_BAR; PG8_WAIT_L(0); PG8_MMA(0, 0, At, B0); PG8_BAR; PG8_SCHED;
            PG8_LDB(B1, 1, 1); PG8_STAGE(PG8_SB(1, 0), b30, voffB);
            PG8_BAR; PG8_WAIT_L(0); PG8_MMA(0, 1, At, B1); PG8_BAR;
            PG8_LDA(At, 1, 1); PG8_STAGE(PG8_SA(1, 0), a3, v2[0]);
            PG8_BAR; PG8_WAIT_L(0); PG8_MMA(1, 0, At, B0); PG8_BAR; PG8_SCHED;
            PG8_STAGE(PG8_SB(1, 1), b31, voffB);
            PG8_WAIT_V(6); PG8_BAR; PG8_MMA(1, 1, At, B1); PG8_BAR;
            }
        }
        if constexpr (ALIGN_EPI) { if (wr == 0) PG8_BAR; }
        E(acc, cur, wr, wc, fr, fq);
        if (!has_next) break;
#pragma unroll
        for (int a = 0; a < 2; ++a)
#pragma unroll
            for (int b = 0; b < 2; ++b)
#pragma unroll
                for (int m = 0; m < 4; ++m)
#pragma unroll
                    for (int n = 0; n < 2; ++n) acc[a][b][m][n] = (f32x4){0.f, 0.f, 0.f, 0.f};
        cur = nxt; cA = nA; ++ui;
#pragma unroll
        for (int h = 0; h < 2; ++h)
#pragma unroll
            for (int i = 0; i < 2; ++i) vA[h][i] = vN[h][i];
        if constexpr (ALIGN_EPI) { if (wr == 1) PG8_BAR; }
    }
    PG8_WAIT_V(0);
    if constexpr (!ALIGN_EPI) { if (wr == 0) PG8_BAR; }
    PG8_BAR;
#undef PG8_SA
#undef PG8_SB
#undef PG8_STAGE
#undef PG8_LDA
#undef PG8_LDB
#undef PG8_MMA
#undef PG8_WAIT_V
#undef PG8_WAIT_L
#undef PG8_BAR
#undef PG8_SCHED
}
}

#define XB_TMO      128
#define XB_XCNT(j)  (256  + 64 * (j))
#define XB_XSUB(j)  (1280 + 64 * (j))
#define XB_XGEN(j)  (2304 + 64 * (j))
#define XB_TOP      3328
#define XB_TOPGEN   3392
#define XCD_BAR_WORDS 3456
#define XB_SPIN_CAP (1u << 18)
__device__ __forceinline__ unsigned xb_ld(unsigned* p)              { return __hip_atomic_load(p, __ATOMIC_RELAXED, __HIP_MEMORY_SCOPE_AGENT); }
__device__ __forceinline__ unsigned xb_add(unsigned* p, unsigned v) { return __hip_atomic_fetch_add(p, v, __ATOMIC_RELAXED, __HIP_MEMORY_SCOPE_AGENT); }
__device__ __forceinline__ unsigned xb_xcc_id() { return (unsigned)__builtin_amdgcn_s_getreg((3 << 11) | 20) & 0xFu; }
#define XB_SPIN(cond, bar) do { unsigned _sp = 0; while (cond) { __builtin_amdgcn_s_sleep(1); \
    if ((++_sp & 255u) == 0u) { if (xb_ld(&(bar)[XB_TMO])) break; if (_sp > XB_SPIN_CAP) { atomicAdd(&(bar)[XB_TMO], 1u); break; } } } } while (0)
struct XcdBarrier { unsigned* bar; unsigned x; volatile LAS unsigned* st; };
__device__ __forceinline__ XcdBarrier xcd_barrier_post(unsigned* bar, volatile LAS unsigned* st) {
    XcdBarrier b; b.bar = bar; b.x = xb_xcc_id(); b.st = st;
    if (threadIdx.x == 0) (void)xb_add(&bar[XB_XCNT(b.x)], 1u);
    return b;
}
__device__ __forceinline__ void xcd_barrier_complete(unsigned* bar, unsigned x, unsigned& nloc, unsigned& nx) {
    const unsigned G = gridDim.x * gridDim.y * gridDim.z;
    unsigned sum, cnt, mine, sp = 0u;
    for (;;) {
        sum = 0u; cnt = 0u; mine = 0u;
#pragma unroll
        for (unsigned j = 0; j < 16; ++j) { const unsigned c = xb_ld(&bar[XB_XCNT(j)]); sum += c; cnt += (c > 0u) ? 1u : 0u; mine = (j == x) ? c : mine; }
        if (sum == G) break;
        __builtin_amdgcn_s_sleep(1);
        if ((++sp & 255u) == 0u) { if (xb_ld(&bar[XB_TMO])) break; if (sp > XB_SPIN_CAP) { atomicAdd(&bar[XB_TMO], 1u); break; } }
    }
    nloc = mine > 0u ? mine : 1u; nx = cnt > 0u ? cnt : 1u;
}
__device__ __forceinline__ void xcd_barrier(const XcdBarrier& b) {
    asm volatile("s_waitcnt vmcnt(0)" ::: "memory");
    __syncthreads();
    if (threadIdx.x == 0) {
        unsigned* bar = b.bar;
        __builtin_amdgcn_s_waitcnt(0);
        unsigned nloc = b.st[0], nx = b.st[1];
        if (nloc == 0u) { xcd_barrier_complete(bar, b.x, nloc, nx); b.st[0] = nloc; b.st[1] = nx; }
        const unsigned old = xb_add(&bar[XB_XSUB(b.x)], 1u);
        const unsigned gen = old / nloc;
        if (old + 1u == (gen + 1u) * nloc) {
            __builtin_amdgcn_fence(__ATOMIC_RELEASE, "agent");
            asm volatile("s_waitcnt vmcnt(0)" ::: "memory");
            const unsigned og = xb_add(&bar[XB_TOP], 1u);
            const unsigned tg = og / nx;
            if (og + 1u == (tg + 1u) * nx) xb_add(&bar[XB_TOPGEN], 1u);
            else XB_SPIN(xb_ld(&bar[XB_TOPGEN]) == tg, bar);
            __builtin_amdgcn_fence(__ATOMIC_ACQUIRE, "agent");
            xb_add(&bar[XB_XGEN(b.x)], 1u);
            asm volatile("s_waitcnt vmcnt(0)" ::: "memory");
        } else {
            XB_SPIN(xb_ld(&bar[XB_XGEN(b.x)]) == gen, bar);
            __builtin_amdgcn_fence(__ATOMIC_ACQUIRE, "agent");
            asm volatile("s_waitcnt vmcnt(0)" ::: "memory");
        }
    }
    __syncthreads();
}

struct Frame {
    LAS unsigned char* lds;
    volatile LAS unsigned* MISC;
    gu32* ctl;
    int tid, lane, wave, vcu, G;
    unsigned char* ws; float* out;
    const float *x, *w_in, *w_out, *g_mix, *g_ffn, *g_fin, *g_att, *rel_bias, *dec_f, *dec_b, *rgw, *rgb, *rew, *reb, *w1, *w3, *w2;
    bf16 *WinT, *WoutT, *W1T, *W3T, *W2T, *XN, *PROJ, *MIX, *HID;
    float *COS, *SIN, *BIAS, *KV;
    bf16* ATTO; float* ATTL;
    ListEnt* LIST;
};

__device__ __forceinline__ void p0_transpose_item(const float* W, int K, int N, bf16* WT, int row_off, LAS float* scr, int item, int lane, const float* ksc, int klim, float csc) {
    const int nblk = N / 32, kb = item / nblk, nb = item % nblk, k0 = 64 * kb, n0 = 32 * nb;
#pragma unroll 8
    for (int i = 0; i < 32; ++i) { const int kk = 2 * i + (lane >> 5); const int k = k0 + kk; float s = csc; if (ksc && k < klim) s *= ksc[k];
        scr[kk * 33 + (lane & 31)] = W[(size_t)k * N + n0 + (lane & 31)] * s; }
    LDS_WAIT(); asm volatile("" ::: "memory");
    const int c = lane & 7;
#pragma unroll
    for (int j = 0; j < 4; ++j) { const int n = (lane >> 3) + 8 * j; const LAS float* s = scr + (8 * c) * 33 + n;
        v4u o; o.x = pk2(s[0 * 33], s[1 * 33]); o.y = pk2(s[2 * 33], s[3 * 33]); o.z = pk2(s[4 * 33], s[5 * 33]); o.w = pk2(s[6 * 33], s[7 * 33]);
        *(GAS v4u*)(WT + (size_t)(row_off + n0 + n) * K + k0 + 8 * c) = o; }
    LDS_WAIT(); asm volatile("" ::: "memory");
}
__device__ __forceinline__ int t5_bucket(int rel) {
    const int n = rel < 0 ? -rel : rel; const int off = rel > 0 ? 16 : 0;
    if (n < 8) return off + n;
    int large = 8 + (int)(logf((float)n / 8.0f) / logf(128.0f) * 8.0f);
    if (large > 15) large = 15;
    return off + large;
}
__device__ __forceinline__ void p0_prologue(Frame& F) {
    LAS float* scr = (LAS float*)(F.lds + RING_OFF + F.wave * 16384);
    const int gw = F.vcu * NWAVES + F.wave, NGW = F.G * NWAVES;
    constexpr int I_IN = (D / 64) * (PW / 32), I_OUT = (D / 64) * (D / 32), I_UP = (D / 64) * (FF / 32), I_DN = (FF / 64) * (D / 32);
    constexpr int NITEMS = I_IN + I_OUT + NE * (2 * I_UP + I_DN);
    for (int it = gw; it < NITEMS; it += NGW) {
        int r = it;
        if (r < I_IN) { const int n0 = 32 * (r % (PW / 32)); const float csc = (n0 < C_AK || (n0 >= C_RK && n0 < C_RV)) ? 0.125f : 1.0f;
            p0_transpose_item(F.w_in, D, PW, F.WinT, 0, scr, r, F.lane, F.g_mix, D, csc); continue; } r -= I_IN;
        if (r < I_OUT) { p0_transpose_item(F.w_out, D, D, F.WoutT, 0, scr, r, F.lane, F.g_att, 512, 1.0f); continue; } r -= I_OUT;
        const int e = r / (2 * I_UP + I_DN); r -= e * (2 * I_UP + I_DN);
        if (r < I_UP) { p0_transpose_item(F.w1 + (size_t)e * D * FF, D, FF, F.W1T + (size_t)e * FF * D, 0, scr, r, F.lane, F.g_ffn, D, 1.0f); continue; } r -= I_UP;
        if (r < I_UP) { p0_transpose_item(F.w3 + (size_t)e * D * FF, D, FF, F.W3T + (size_t)e * FF * D, 0, scr, r, F.lane, F.g_ffn, D, 1.0f); continue; } r -= I_UP;
        p0_transpose_item(F.w2 + (size_t)e * FF * D, FF, D, F.W2T + (size_t)e * D * FF, 0, scr, r, F.lane, nullptr, 0, 1.0f);
    }
    for (int m = gw; m < M; m += NGW) {
        const GAS f32x4* xr = (const GAS f32x4*)(F.x + (size_t)m * D) + F.lane;
        f32x4 v[4]; float s = 0.f;
#pragma unroll
        for (int j = 0; j < 4; ++j) { v[j] = xr[64 * j]; s += (v[j].x * v[j].x + v[j].y * v[j].y) + (v[j].z * v[j].z + v[j].w * v[j].w); }
        const float rstd = 1.f / sqrtf(wave_sum(s) * (1.f / D) + EPS);
        GAS unsigned long long* o8 = (GAS unsigned long long*)(F.XN + (size_t)m * D) + F.lane;
#pragma unroll
        for (int j = 0; j < 4; ++j) o8[64 * j] = (unsigned long long)pk2(v[j].x * rstd, v[j].y * rstd) | ((unsigned long long)pk2(v[j].z * rstd, v[j].w * rstd) << 32);
    }
    const int gt = F.vcu * 512 + F.tid, NGT = F.G * 512;
    for (int i = gt; i < SEQ * 32; i += NGT) {
        const int pos = i >> 5, fi = i & 31;
        const float inv = powf(10000.0f, -(float)fi / 32.0f);
        const float ang = (float)pos * inv;
        const double a = (double)ang; const double k = rint(a * 0.15915494309189535); const double rr = a - k * 6.283185307179586477;
        F.COS[i] = (float)cos(rr); F.SIN[i] = (float)sin(rr);
    }
    for (int i = gt; i < 3 * NH * 132; i += NGT) {
        const int dl = i % 132, h = (i / 132) % NH, br = i / (132 * NH); const int d = br == 0 ? 1 : (br == 1 ? 4 : 16);
        float v = 0.f; if (dl <= 128) v = F.rel_bias[t5_bucket((dl - 64) * d) * NH + h];
        F.BIAS[i] = v;
    }
}

__device__ __forceinline__ void rotary_inplace(Frame& F) {
    const long gt = (long)F.vcu * 512 + F.tid, NGT = (long)F.G * 512;
    const long total = (long)M * 2 * NH * 8;
    for (long u = gt; u < total; u += NGT) {
        const int g4 = (int)(u & 7), h = (int)((u >> 3) & 7), qk = (int)((u >> 6) & 1); const int tok = (int)(u >> 7);
        const int pos = tok & (SEQ - 1);
        bf16* base = F.PROJ + (size_t)tok * PW + (qk ? C_RK : C_RQ) + h * HD + 4 * g4;
        const v2u a = *(const v2u*)base, b = *(const v2u*)(base + 32);
        const f32x4 c = *(const f32x4*)(F.COS + pos * 32 + 4 * g4), s = *(const f32x4*)(F.SIN + pos * 32 + 4 * g4);
        const float t1[4] = {bf_lo(a.x), bf_hi(a.x), bf_lo(a.y), bf_hi(a.y)}, t2[4] = {bf_lo(b.x), bf_hi(b.x), bf_lo(b.y), bf_hi(b.y)};
        float o1[4], o2[4];
#pragma unroll
        for (int j = 0; j < 4; ++j) { o1[j] = t1[j] * c[j] - t2[j] * s[j]; o2[j] = t1[j] * s[j] + t2[j] * c[j]; }
        v2u wa, wb; wa.x = pk2(o1[0], o1[1]); wa.y = pk2(o1[2], o1[3]); wb.x = pk2(o2[0], o2[1]); wb.y = pk2(o2[2], o2[3]);
        *(v2u*)base = wa; *(v2u*)(base + 32) = wb;
    }
}
__device__ __forceinline__ void load_row64(const bf16* p, float (&v)[64]) {
#pragma unroll
    for (int c = 0; c < 8; ++c) { const v4u w = *(const v4u*)(p + 8 * c);
        v[8 * c + 0] = bf_lo(w.x); v[8 * c + 1] = bf_hi(w.x); v[8 * c + 2] = bf_lo(w.y); v[8 * c + 3] = bf_hi(w.y);
        v[8 * c + 4] = bf_lo(w.z); v[8 * c + 5] = bf_hi(w.z); v[8 * c + 6] = bf_lo(w.w); v[8 * c + 7] = bf_hi(w.w); }
}
__device__ __forceinline__ void attn_naive(Frame& F) {
    const long gt = (long)F.vcu * 512 + F.tid, NGT = (long)F.G * 512;
    const long total = 3L * NB * NH * SEQ;
    for (long u = gt; u < total; u += NGT) {
        const int p = (int)(u & (SEQ - 1)), h = (int)((u >> 11) & 7), b = (int)((u >> 14) & 7), br = (int)(u >> 17);
        const int sh = 2 * br, d = 1 << sh, r = p & (d - 1), a = p >> sh, L = SEQ >> sh;
        float q[64]; load_row64(F.PROJ + (size_t)(b * SEQ + p) * PW + C_AQ + h * HD, q);
        float acc[64];
#pragma unroll
        for (int i = 0; i < 64; ++i) acc[i] = 0.f;
        float mx = -1e30f, l = 0.f;
        const int j0 = a - 64 < 0 ? 0 : a - 64, j1 = a + 64 > L - 1 ? L - 1 : a + 64;
        const float* bias = F.BIAS + (br * NH + h) * 132 + 64;
        for (int j = j0; j <= j1; ++j) {
            const size_t row = (size_t)(b * SEQ + (j << sh) + r) * PW;
            float kv[64]; load_row64(F.PROJ + row + C_AK + h * HD, kv);
            float s = 0.f;
#pragma unroll
            for (int i = 0; i < 64; ++i) s += q[i] * kv[i];
            s += bias[j - a];
            const float mn = fmaxf(mx, s), sc = __expf(mx - mn), pp = __expf(s - mn);
            load_row64(F.PROJ + row + C_AV + h * HD, kv);
            l = l * sc + pp;
#pragma unroll
            for (int i = 0; i < 64; ++i) acc[i] = acc[i] * sc + pp * kv[i];
            mx = mn;
        }
        const float il = 1.f / l;
        bf16* o = F.ATTO + ((size_t)br * M + (size_t)(b * SEQ + p)) * 512 + h * HD;
#pragma unroll
        for (int c = 0; c < 8; ++c) { v4u w; w.x = pk2(acc[8 * c] * il, acc[8 * c + 1] * il); w.y = pk2(acc[8 * c + 2] * il, acc[8 * c + 3] * il);
            w.z = pk2(acc[8 * c + 4] * il, acc[8 * c + 5] * il); w.w = pk2(acc[8 * c + 6] * il, acc[8 * c + 7] * il); *(v4u*)(o + 8 * c) = w; }
        F.ATTL[((size_t)br * M + (size_t)(b * SEQ + p)) * NH + h] = mx + __logf(l);
    }
}
__device__ __forceinline__ void ret_naive(Frame& F) {
    const long gt = (long)F.vcu * 512 + F.tid, NGT = (long)F.G * 512;
    const long total = (long)NB * NH * SEQ;
    for (long u = gt; u < total; u += NGT) {
        const int n = (int)(u & (SEQ - 1)), h = (int)((u >> 11) & 7), b = (int)(u >> 14);
        const float lgf = -__expf(F.dec_f[h]) * 1.4426950408889634f, lgb = -__expf(F.dec_b[h]) * 1.4426950408889634f;
        float q[64]; load_row64(F.PROJ + (size_t)(b * SEQ + n) * PW + C_RQ + h * HD, q);
        float acc[64];
#pragma unroll
        for (int i = 0; i < 64; ++i) acc[i] = 0.f;
        for (int m = 0; m < SEQ; ++m) {
            const size_t row = (size_t)(b * SEQ + m) * PW;
            float kv[64]; load_row64(F.PROJ + row + C_RK + h * HD, kv);
            float s = 0.f;
#pragma unroll
            for (int i = 0; i < 64; ++i) s += q[i] * kv[i];
            const float dec = (m <= n) ? exp2f(lgf * (float)(n - m)) : exp2f(lgb * (float)(m - n));
            s *= dec;
            load_row64(F.PROJ + row + C_RV + h * HD, kv);
#pragma unroll
            for (int i = 0; i < 64; ++i) acc[i] += s * kv[i];
        }
        float ss = 0.f;
#pragma unroll
        for (int i = 0; i < 64; ++i) ss += acc[i] * acc[i];
        const float rs = 1.f / sqrtf(ss * (1.f / 64.f) + EPS);
        float g[64]; load_row64(F.PROJ + (size_t)(b * SEQ + n) * PW + C_RG + h * HD, g);
        bf16* o = F.MIX + (size_t)(b * SEQ + n) * D + 512 + h * HD;
        float y[64];
#pragma unroll
        for (int i = 0; i < 64; ++i) { const float gg = g[i]; y[i] = acc[i] * rs * (gg / (1.f + __expf(-gg))); }
#pragma unroll
        for (int c = 0; c < 8; ++c) { v4u w; w.x = pk2(y[8 * c], y[8 * c + 1]); w.y = pk2(y[8 * c + 2], y[8 * c + 3]); w.z = pk2(y[8 * c + 4], y[8 * c + 5]); w.w = pk2(y[8 * c + 6], y[8 * c + 7]); *(v4u*)(o + 8 * c) = w; }
    }
}
__device__ __forceinline__ void attn_combine(Frame& F) {
    const int gw = F.vcu * NWAVES + F.wave, NGW = F.G * NWAVES;
    for (int tok = gw; tok < M; tok += NGW) {
        const int h = F.lane >> 3;
        const float l0 = F.ATTL[((size_t)0 * M + tok) * NH + h], l1 = F.ATTL[((size_t)1 * M + tok) * NH + h], l2 = F.ATTL[((size_t)2 * M + tok) * NH + h];
        const float mx = fmaxf(l0, fmaxf(l1, l2)); const float e0 = __expf(l0 - mx), e1 = __expf(l1 - mx), e2 = __expf(l2 - mx); const float inv = 1.f / (e0 + e1 + e2);
        const float w0 = e0 * inv, w1 = e1 * inv, w2 = e2 * inv;
        const v4u a = *(const v4u*)(F.ATTO + ((size_t)0 * M + tok) * 512 + 8 * F.lane), b = *(const v4u*)(F.ATTO + ((size_t)1 * M + tok) * 512 + 8 * F.lane), c = *(const v4u*)(F.ATTO + ((size_t)2 * M + tok) * 512 + 8 * F.lane);
        float o[8];
        o[0] = w0 * bf_lo(a.x) + w1 * bf_lo(b.x) + w2 * bf_lo(c.x); o[1] = w0 * bf_hi(a.x) + w1 * bf_hi(b.x) + w2 * bf_hi(c.x);
        o[2] = w0 * bf_lo(a.y) + w1 * bf_lo(b.y) + w2 * bf_lo(c.y); o[3] = w0 * bf_hi(a.y) + w1 * bf_hi(b.y) + w2 * bf_hi(c.y);
        o[4] = w0 * bf_lo(a.z) + w1 * bf_lo(b.z) + w2 * bf_lo(c.z); o[5] = w0 * bf_hi(a.z) + w1 * bf_hi(b.z) + w2 * bf_hi(c.z);
        o[6] = w0 * bf_lo(a.w) + w1 * bf_lo(b.w) + w2 * bf_lo(c.w); o[7] = w0 * bf_hi(a.w) + w1 * bf_hi(b.w) + w2 * bf_hi(c.w);
        float ss = 0.f;
#pragma unroll
        for (int i = 0; i < 8; ++i) ss += o[i] * o[i];
        const float rs = 1.f / sqrtf(wave_sum(ss) * (1.f / 512.f) + EPS);
        v4u w; w.x = pk2(o[0] * rs, o[1] * rs); w.y = pk2(o[2] * rs, o[3] * rs); w.z = pk2(o[4] * rs, o[5] * rs); w.w = pk2(o[6] * rs, o[7] * rs);
        *(v4u*)(F.MIX + (size_t)tok * D + 8 * F.lane) = w;
    }
}
__device__ __forceinline__ void router(Frame& F) {
    LAS int* s_cls = (LAS int*)(F.lds + RT_OFF); LAS float* s_glo = (LAS float*)(F.lds + RT_OFF + 256); LAS float* s_ghi = (LAS float*)(F.lds + RT_OFF + 512);
    LAS int* s_base = (LAS int*)(F.lds + RT_OFF + 768);
    const float* h1 = F.out;
    for (int blk = F.vcu; blk < M / 64; blk += F.G) {
        for (int t = 0; t < 8; ++t) {
            const int tl = F.wave * 8 + t, tok = blk * 64 + tl;
            const GAS f32x4* hr = (const GAS f32x4*)(h1 + (size_t)tok * D) + F.lane;
            f32x4 v[4]; float s = 0.f;
#pragma unroll
            for (int j = 0; j < 4; ++j) { v[j] = hr[64 * j]; s += (v[j].x * v[j].x + v[j].y * v[j].y) + (v[j].z * v[j].z + v[j].w * v[j].w); }
            const float rstd = 1.f / sqrtf(wave_sum(s) * (1.f / D) + EPS);
            GAS unsigned long long* o8 = (GAS unsigned long long*)(F.XN + (size_t)tok * D) + F.lane;
            float gl[4] = {0.f, 0.f, 0.f, 0.f};
#pragma unroll
            for (int j = 0; j < 4; ++j) { const int k = 4 * F.lane + 256 * j; v[j] = v[j] * rstd;
                o8[64 * j] = (unsigned long long)pk2(v[j].x, v[j].y) | ((unsigned long long)pk2(v[j].z, v[j].w) << 32);
                const f32x4 gn = *(const f32x4*)(F.g_ffn + k); v[j] = v[j] * gn;
#pragma unroll
                for (int e = 0; e < 4; ++e) { const f32x4 wg = *(const f32x4*)(F.rgw + (size_t)(k + e) * 4);
                    gl[0] += v[j][e] * wg.x; gl[1] += v[j][e] * wg.y; gl[2] += v[j][e] * wg.z; gl[3] += v[j][e] * wg.w; } }
#pragma unroll
            for (int e = 0; e < 4; ++e) gl[e] = wave_sum(gl[e]) + F.rgb[e];
            int g = 0; float gm = gl[0];
#pragma unroll
            for (int e = 1; e < 4; ++e) if (gl[e] > gm) { gm = gl[e]; g = e; }
            const float pg = 1.f / (__expf(gl[0] - gm) + __expf(gl[1] - gm) + __expf(gl[2] - gm) + __expf(gl[3] - gm));
            float el[4] = {0.f, 0.f, 0.f, 0.f};
            const float* we = F.rew + (size_t)g * D * 4;
#pragma unroll
            for (int j = 0; j < 4; ++j) { const int k = 4 * F.lane + 256 * j;
#pragma unroll
                for (int e = 0; e < 4; ++e) { const f32x4 w = *(const f32x4*)(we + (size_t)(k + e) * 4);
                    el[0] += v[j][e] * w.x; el[1] += v[j][e] * w.y; el[2] += v[j][e] * w.z; el[3] += v[j][e] * w.w; } }
#pragma unroll
            for (int e = 0; e < 4; ++e) el[e] = wave_sum(el[e]) + F.reb[g * 4 + e];
            int i1 = 0; float v1 = el[0];
#pragma unroll
            for (int e = 1; e < 4; ++e) if (el[e] > v1) { v1 = el[e]; i1 = e; }
            int i2 = -1; float v2 = -3.0e38f;
#pragma unroll
            for (int e = 0; e < 4; ++e) if (e != i1 && el[e] > v2) { v2 = el[e]; i2 = e; }
            const float p2 = 1.f / (1.f + __expf(v1 - v2)), p1 = 1.f - p2;
            const int lo = i1 < i2 ? i1 : i2, hi = i1 < i2 ? i2 : i1;
            const float glo = pg * (i1 < i2 ? p1 : p2), ghi = pg * (i1 < i2 ? p2 : p1);
            const int pidx = lo == 0 ? hi - 1 : (lo == 1 ? 1 + hi : 5);
            if (F.lane == 0) { s_cls[tl] = g * 6 + pidx; s_glo[tl] = glo; s_ghi[tl] = ghi; }
        }
        LDS_WAIT(); __syncthreads();
        if (F.tid < NCLS) { int n = 0;
            for (int i = 0; i < 64; ++i) n += (s_cls[i] == F.tid) ? 1 : 0;
            int base = 0; if (n > 0) base = (int)__hip_atomic_fetch_add((unsigned*)(F.ctl + CW_CLS + 64 * F.tid), (unsigned)n, RLX_AGENT);
            s_base[F.tid] = base; }
        LDS_WAIT(); __syncthreads();
        if (F.tid < 64) { const int c = s_cls[F.tid]; int rank = 0;
            for (int i = 0; i < F.tid; ++i) rank += (s_cls[i] == c) ? 1 : 0;
            ListEnt e; e.tok = blk * 64 + F.tid; e.glo = s_glo[F.tid]; e.ghi = s_ghi[F.tid]; e.pad = 0;
            F.LIST[(size_t)c * LCAP + s_base[c] + rank] = e; }
        LDS_WAIT(); __syncthreads();
    }
}
__device__ __forceinline__ void cls_experts(int cls, int& elo, int& ehi) { const int g = cls / 6, p = cls % 6; const int lo = p < 3 ? 0 : (p < 5 ? 1 : 2), hi = p < 3 ? p + 1 : (p < 5 ? p - 1 : 3); elo = 4 * g + lo; ehi = 4 * g + hi; }
__device__ __forceinline__ void moe_tab_build(Frame& F) {
    LAS int* tab = (LAS int*)(F.lds + MOETAB_OFF);
    if (F.tid == 0) { int t = 0;
        for (int c = 0; c < NCLS; ++c) { const int n = (int)__hip_atomic_load((unsigned*)(F.ctl + CW_CLS + 64 * c), RLX_AGENT); tab[c] = n; tab[32 + c] = t; t += (n + 255) >> 8; }
        tab[32 + NCLS] = t; }
    LDS_WAIT(); __syncthreads();
}
struct MoeOrderBase {
    const LAS int* tab; int G, c, ncol, nunits;
    __device__ __forceinline__ bool decode(int i, pg8::Unit& u) const {
        const long L = (long)i * G + c; if (L >= nunits) return false;
        const int wgid = pg8::xcd_remap((int)L, nunits);
        const int rt = wgid / ncol; u.pm = rt; u.pn = wgid % ncol;
        int cls = 0;
        for (int k = 1; k < NCLS; ++k) if (rt >= tab[32 + k]) cls = k;
        u.x0 = cls; u.x1 = tab[cls] - (rt - tab[32 + cls]) * 256;
        return true;
    }
};
struct UpOrder : MoeOrderBase {
    static constexpr bool GATHER = true;
    const bf16* HN; const bf16* W1T; const bf16* W3T; const ListEnt* list;
    __device__ __forceinline__ bool next(int i, pg8::Unit& u) const { return decode(i, u); }
    __device__ __forceinline__ const char* a_base(const pg8::Unit&) const { return (const char*)HN; }
    __device__ __forceinline__ void a_voff(const pg8::Unit& u, const int (&R)[2], const int (&C)[2], unsigned (&v)[2][2]) const {
        const int slot0 = (u.pm - tab[32 + u.x0]) * 256;
#pragma unroll
        for (int h = 0; h < 2; ++h)
#pragma unroll
            for (int i = 0; i < 2; ++i) { const int r = h * 128 + R[i]; int tok = 0; if (r < u.x1) tok = list[(size_t)u.x0 * LCAP + slot0 + r].tok;
                v[h][i] = (unsigned)(tok * D + C[i]) * 2u; }
    }
    __device__ __forceinline__ const char* b_base(const pg8::Unit& u, int half, int kt) const {
        int elo, ehi; cls_experts(u.x0, elo, ehi); const int e = u.pn < 4 ? elo : ehi;
        const bf16* W = half ? W3T : W1T;
        return (const char*)W + ((size_t)(e * FF + (u.pn & 3) * 128) * D + (size_t)kt * 64) * 2;
    }
};
struct DownOrder : MoeOrderBase {
    static constexpr bool GATHER = false;
    const bf16* HID; const bf16* W2T;
    __device__ __forceinline__ bool next(int i, pg8::Unit& u) const { return decode(i, u); }
    __device__ __forceinline__ const char* a_base(const pg8::Unit& u) const { return (const char*)HID + (size_t)u.pm * 256 * D * 2; }
    __device__ __forceinline__ void a_voff(const pg8::Unit&, const int (&R)[2], const int (&C)[2], unsigned (&v)[2][2]) const {
#pragma unroll
        for (int h = 0; h < 2; ++h)
#pragma unroll
            for (int i = 0; i < 2; ++i) v[h][i] = (unsigned)((h * 128 + R[i]) * D + C[i]) * 2u;
    }
    __device__ __forceinline__ const char* b_base(const pg8::Unit& u, int half, int kt) const {
        int elo, ehi; cls_experts(u.x0, elo, ehi); const int e = kt < 8 ? elo : ehi;
        return (const char*)W2T + ((size_t)(e * D + u.pn * 256 + half * 128) * FF + (size_t)(kt & 7) * 64) * 2;
    }
};
struct EpiUp {
    static constexpr bool PERM = true;
    bf16* HID; const ListEnt* list; const LAS int* tab;
    __device__ __forceinline__ void operator()(const f32x4 (&acc)[2][2][4][2], const pg8::Unit& u, int wr, int wc, int fr, int fq) const {
        const int slot0 = (u.pm - tab[32 + u.x0]) * 256; const bool usehi = u.pn >= 4;
#pragma unroll
        for (int ai = 0; ai < 2; ++ai)
#pragma unroll
            for (int m = 0; m < 4; ++m) { const int r = ai * 128 + wr * 64 + m * 16 + fr;
                float gate = 0.f; if (r < u.x1) { const ListEnt* e = list + (size_t)u.x0 * LCAP + slot0 + r; gate = usehi ? e->ghi : e->glo; }
                const f32x4 a0 = acc[ai][0][m][0], a1 = acc[ai][0][m][1], b0 = acc[ai][1][m][0], b1 = acc[ai][1][m][1];
                float o[8];
#pragma unroll
                for (int j = 0; j < 4; ++j) { o[j] = a0[j] / (1.f + __expf(-a0[j])) * b0[j] * gate; o[4 + j] = a1[j] / (1.f + __expf(-a1[j])) * b1[j] * gate; }
                pg8::u32x4 w; w.x = pg8::cvt_pk_bf16(o[0], o[1]); w.y = pg8::cvt_pk_bf16(o[2], o[3]); w.z = pg8::cvt_pk_bf16(o[4], o[5]); w.w = pg8::cvt_pk_bf16(o[6], o[7]);
                *(pg8::u32x4*)(HID + (size_t)(u.pm * 256 + r) * D + u.pn * 128 + wc * 32 + 8 * fq) = w; }
    }
};
struct EpiDown {
    static constexpr bool PERM = false;
    float* out; const ListEnt* list; const LAS int* tab;
    __device__ __forceinline__ void operator()(const f32x4 (&acc)[2][2][4][2], const pg8::Unit& u, int wr, int wc, int fr, int fq) const {
        const int slot0 = (u.pm - tab[32 + u.x0]) * 256; const int col0 = u.pn * 256 + wc * 32 + 4 * fq;
#pragma unroll
        for (int ai = 0; ai < 2; ++ai)
#pragma unroll
            for (int m = 0; m < 4; ++m) { const int r = ai * 128 + wr * 64 + m * 16 + fr;
                if (r < u.x1) { const int tok = list[(size_t)u.x0 * LCAP + slot0 + r].tok; float* rowp = out + (size_t)tok * D + col0;
#pragma unroll
                    for (int bj = 0; bj < 2; ++bj)
#pragma unroll
                        for (int n = 0; n < 2; ++n) { const f32x4 h = *(const f32x4*)(rowp + bj * 128 + n * 16); *(f32x4*)(rowp + bj * 128 + n * 16) = h + acc[ai][bj][m][n]; } }
                asm volatile("" ::: "memory"); }
    }
};
__device__ __forceinline__ void final_norm(Frame& F) {
    const int gw = F.vcu * NWAVES + F.wave, NGW = F.G * NWAVES;
    for (int m = gw; m < M; m += NGW) {
        GAS f32x4* xr = (GAS f32x4*)(F.out + (size_t)m * D) + F.lane;
        f32x4 v[4]; float s = 0.f;
#pragma unroll
        for (int j = 0; j < 4; ++j) { v[j] = xr[64 * j]; s += (v[j].x * v[j].x + v[j].y * v[j].y) + (v[j].z * v[j].z + v[j].w * v[j].w); }
        const float rstd = 1.f / sqrtf(wave_sum(s) * (1.f / D) + EPS);
#pragma unroll
        for (int j = 0; j < 4; ++j) { const f32x4 g = *(const f32x4*)(F.g_fin + 4 * F.lane + 256 * j); xr[64 * j] = v[j] * rstd * g; }
    }
}

constexpr int NPHASE = 9;
struct Args { const float* in[17]; float* out; unsigned char* ws; int ph_lo, ph_hi; };
__global__ void __launch_bounds__(NWAVES * 64, 2) hybrid_fwd(Args args) {
    extern __shared__ __attribute__((aligned(16))) unsigned char lds[];
    Frame F;
    F.lds = (LAS unsigned char*)lds;
    F.MISC = (volatile LAS unsigned*)(F.lds + MISC_OFF);
    F.tid = threadIdx.x; F.lane = F.tid & 63; F.wave = __builtin_amdgcn_readfirstlane(F.tid >> 6);
    F.G = gridDim.x; { const int bx = blockIdx.x; F.vcu = (F.G % 8 == 0) ? (bx % 8) * (F.G / 8) + bx / 8 : bx; }
    unsigned char* ws = args.ws; F.ws = ws; F.out = args.out;
    F.ctl = (gu32*)(ws + WS_CTL);
    F.x = args.in[0]; F.w_in = args.in[1]; F.w_out = args.in[2]; F.g_mix = args.in[3]; F.g_ffn = args.in[4]; F.g_fin = args.in[5]; F.g_att = args.in[6]; F.rel_bias = args.in[7];
    F.dec_f = args.in[8]; F.dec_b = args.in[9]; F.rgw = args.in[10]; F.rgb = args.in[11]; F.rew = args.in[12]; F.reb = args.in[13]; F.w1 = args.in[14]; F.w3 = args.in[15]; F.w2 = args.in[16];
    F.WinT = (bf16*)(ws + WS_WIN); F.WoutT = (bf16*)(ws + WS_WOUT); F.W1T = (bf16*)(ws + WS_W1); F.W3T = (bf16*)(ws + WS_W3); F.W2T = (bf16*)(ws + WS_W2);
    F.XN = (bf16*)(ws + WS_XN); F.PROJ = (bf16*)(ws + WS_PROJ); F.MIX = (bf16*)(ws + WS_MIX); F.HID = (bf16*)(ws + WS_PROJ);
    F.COS = (float*)(ws + WS_COS); F.SIN = (float*)(ws + WS_SIN); F.BIAS = (float*)(ws + WS_BIAS); F.KV = (float*)(ws + WS_XN);
    F.ATTO = (bf16*)((unsigned char*)args.out + DO_ATTO); F.ATTL = (float*)((unsigned char*)args.out + DO_ATTL);
    F.LIST = (ListEnt*)(ws + WS_LIST);
    for (int u = F.tid; u < (LDS_BYTES - LDSCTL_OFF) / 4; u += NWAVES * 64) ((LAS unsigned*)(F.lds + LDSCTL_OFF))[u] = 0u;
    __syncthreads();
#if MK_PER_PHASE
#define GRID_BAR() do { } while (0)
#else
    XcdBarrier bar = xcd_barrier_post((unsigned*)(F.ctl + CW_BAR), F.MISC + 8);
#define GRID_BAR() xcd_barrier(bar)
#endif
    const int lo = args.ph_lo, hi = args.ph_hi;
#define IN(k) (lo <= (k) && (k) < hi)
#define BOTH(k) (IN(k) && IN((k) + 1))

    if (IN(0)) { p0_prologue(F); if (BOTH(0)) GRID_BAR(); }
    if (IN(1)) {
        pg8::DenseOrder S; S.init(F.XN, F.WinT, M, PW, D, D, F.G, (int)blockIdx.x);
        pg8::EpiBf16 E{F.PROJ, PW};
        pg8::gemm_phase<pg8::EpiBf16, pg8::DenseOrder, true, true>(F.lds + RING_OFF, S, E, D, D);
        if (BOTH(1)) GRID_BAR();
    }
    if (IN(2)) { rotary_inplace(F); attn_naive(F); if (BOTH(2)) GRID_BAR(); }
    if (IN(3)) { ret_naive(F); attn_combine(F); if (BOTH(3)) GRID_BAR(); }
    if (IN(4)) {
        pg8::DenseOrder S; S.init(F.MIX, F.WoutT, M, D, D, D, F.G, (int)blockIdx.x);
        pg8::EpiResF32 E{F.x, F.out, D};
        pg8::gemm_phase<pg8::EpiResF32, pg8::DenseOrder, true, true>(F.lds + RING_OFF, S, E, D, D);
        if (BOTH(4)) GRID_BAR();
    }
    if (IN(5)) { router(F); if (BOTH(5)) GRID_BAR(); }
    if (IN(6)) {
        moe_tab_build(F);
        const LAS int* tab = (const LAS int*)(F.lds + MOETAB_OFF);
        UpOrder S; S.tab = tab; S.G = F.G; S.c = (int)blockIdx.x; S.ncol = 8; S.nunits = tab[32 + NCLS] * 8; S.HN = F.XN; S.W1T = F.W1T; S.W3T = F.W3T; S.list = F.LIST;
        EpiUp E{F.HID, F.LIST, tab};
        pg8::gemm_phase<EpiUp, UpOrder, true, true>(F.lds + RING_OFF, S, E, D, D);
        if (BOTH(6)) GRID_BAR();
    }
    if (IN(7)) {
        moe_tab_build(F);
        const LAS int* tab = (const LAS int*)(F.lds + MOETAB_OFF);
        DownOrder S; S.tab = tab; S.G = F.G; S.c = (int)blockIdx.x; S.ncol = 4; S.nunits = tab[32 + NCLS] * 4; S.HID = F.HID; S.W2T = F.W2T;
        EpiDown E{F.out, F.LIST, tab};
        pg8::gemm_phase<EpiDown, DownOrder, true, true>(F.lds + RING_OFF, S, E, FF, D);
        if (BOTH(7)) GRID_BAR();
    }
    if (IN(8)) { final_norm(F); }
#undef IN
#undef BOTH
}

extern "C" void kernel_launch(void* const* d_in, const int* in_sizes, int n_in, void* d_out, int out_size, void* d_ws, size_t ws_size, hipStream_t stream) {
    static int grid = 0;
    if (grid == 0) {
        if (n_in != 17 || in_sizes[0] != M * D || out_size != M * D || ws_size < WS_END) { fprintf(stderr, "kernel_launch: unexpected shapes (n_in %d, in0 %d, out %d, ws %zu)\n", n_in, n_in > 0 ? in_sizes[0] : -1, out_size, ws_size); grid = -1; return; }
        int dev = 0, cus = 0, per_cu = 0;
        if (hipGetDevice(&dev) != hipSuccess || hipDeviceGetAttribute(&cus, hipDeviceAttributeMultiprocessorCount, dev) != hipSuccess) { grid = -1; return; }
        if (hipFuncSetAttribute((const void*)hybrid_fwd, hipFuncAttributeMaxDynamicSharedMemorySize, LDS_BYTES) != hipSuccess) { fprintf(stderr, "kernel_launch: hipFuncSetAttribute failed\n"); grid = -1; return; }
        if (hipOccupancyMaxActiveBlocksPerMultiprocessor(&per_cu, (const void*)hybrid_fwd, NWAVES * 64, LDS_BYTES) != hipSuccess || per_cu < 1)
            fprintf(stderr, "kernel_launch: note: occupancy query reports %d workgroups per CU\n", per_cu);
        (void)hipGetLastError();
        grid = cus;
    }
    if (grid < 0) return;
    if (hipMemsetAsync((char*)d_ws + WS_CTL, 0, CTL_ZERO_BYTES, stream) != hipSuccess) return;
    Args a{};
    for (int i = 0; i < 17; ++i) a.in[i] = (const float*)d_in[i];
    a.out = (float*)d_out; a.ws = (unsigned char*)d_ws;
#if MK_PER_PHASE
    for (int p = 0; p < NPHASE; ++p) { a.ph_lo = p; a.ph_hi = p + 1; hipLaunchKernelGGL(hybrid_fwd, dim3(grid), dim3(NWAVES * 64), LDS_BYTES, stream, a); }
#else
    a.ph_lo = 0; a.ph_hi = NPHASE; hipLaunchKernelGGL(hybrid_fwd, dim3(grid), dim3(NWAVES * 64), LDS_BYTES, stream, a);
#endif
}
```

```cpp
#include <hip/hip_runtime.h>
#include <cstdio>
#include <cstdint>

#ifndef MK_PER_PHASE
#define MK_PER_PHASE 0
#endif

#define GAS __attribute__((address_space(1)))
#define LAS __attribute__((address_space(3)))
typedef unsigned short bf16;
typedef unsigned v4u __attribute__((ext_vector_type(4)));
typedef unsigned v2u __attribute__((ext_vector_type(2)));
typedef float f32x4 __attribute__((ext_vector_type(4)));
typedef float f32x2 __attribute__((ext_vector_type(2)));
typedef short bf16x8 __attribute__((ext_vector_type(8)));
typedef GAS unsigned gu32;
#define RLX_AGENT __ATOMIC_RELAXED, __HIP_MEMORY_SCOPE_AGENT
#define LDS_WAIT() asm volatile("s_waitcnt lgkmcnt(0)" ::: "memory")
#define VM_WAIT() asm volatile("s_waitcnt vmcnt(0)" ::: "memory")

constexpr int NB = 8, SEQ = 2048, D = 1024, M = NB * SEQ, PW = 3584, NH = 8, HD = 64;
constexpr int C_AQ = 0, C_AK = 512, C_AV = 1024, C_RQ = 1536, C_RK = 2048, C_RV = 2560, C_RG = 3072;
constexpr int NE = 16, FF = 512, NCLS = 24, LCAP = 16384;
constexpr float EPS = 1e-6f;
constexpr int RC = 128, NCH = SEQ / RC;

constexpr size_t MiB = 1u << 20;
constexpr size_t WS_CTL = 0, CTL_ZERO_BYTES = 1 * MiB;
constexpr size_t WS_COS = 1 * MiB, WS_SIN = WS_COS + 256 * 1024, WS_BIAS = WS_SIN + 256 * 1024;
constexpr size_t WS_WIN = 4 * MiB, WS_WOUT = 11 * MiB, WS_W1 = 13 * MiB, WS_W3 = 29 * MiB, WS_W2 = 45 * MiB;
constexpr size_t WS_XN = 61 * MiB;
constexpr size_t WS_PROJ = 93 * MiB;
constexpr size_t WS_MIX = 205 * MiB;
constexpr size_t WS_LIST = 237 * MiB;
constexpr size_t WS_END = 243 * MiB;
constexpr size_t DO_ATTO = 0, DO_ATTL = 48 * MiB;
constexpr int CW_TMO = 0, CW_CODE = 1, CW_BAR = 4096, CW_CLS = 16384;

constexpr int RING_OFF = 0, RING_BYTES = 131072;
constexpr int LDSCTL_OFF = RING_BYTES, MISC_OFF = LDSCTL_OFF + 320;
constexpr int MOETAB_OFF = LDSCTL_OFF + 1024;
constexpr int RT_OFF = LDSCTL_OFF + 2048;
constexpr int LDS_BYTES = 147456;
constexpr int NWAVES = 8;

struct ListEnt { int tok; float glo, ghi; int pad; };

__device__ __forceinline__ unsigned f2bf(float f) { unsigned u = __builtin_bit_cast(unsigned, f); return (u + 0x7fffu + ((u >> 16) & 1u)) >> 16; }
__device__ __forceinline__ unsigned pk2(float lo, float hi) { return f2bf(lo) | (f2bf(hi) << 16); }
__device__ __forceinline__ float bf_lo(unsigned w) { return __builtin_bit_cast(float, w << 16); }
__device__ __forceinline__ float bf_hi(unsigned w) { return __builtin_bit_cast(float, w & 0xffff0000u); }
__device__ __forceinline__ float wave_sum(float v) {
#pragma unroll
    for (int o = 1; o < 64; o <<= 1) v += __shfl_xor(v, o);
    return v;
}

namespace pg8 {
#define PG8_LAS __attribute__((address_space(3)))
typedef unsigned short bf16_t;
typedef unsigned u32x4 __attribute__((ext_vector_type(4)));
constexpr int BM = 256, BK = 64, HALF = 128, HTB = HALF * BK * 2, STAGE_BYTES = 8 * HTB, NXCD = 8, WGM = 8;

__host__ __device__ __forceinline__ int lds_byte(int r, int c) { const int st = (r >> 4) * 2 + (c >> 5), rr = r & 15, cc = c & 31, ob = rr * 64 + cc * 2; return st * 1024 + (ob ^ (((ob >> 9) & 1) << 5)); }
__host__ __device__ __forceinline__ void stage_rc(int b, int& R, int& C) { const int st = b / 1024, sb = b % 1024, swz = sb ^ (((sb >> 9) & 1) << 5); R = (st >> 1) * 16 + swz / 64; C = (st & 1) * 32 + (swz % 64) / 2; }
__host__ __device__ __forceinline__ int perm32(int rho) { const int n = rho >> 4, i = rho & 15; return 8 * (i >> 2) + 4 * n + (i & 3); }

struct Unit { int pm, pn, x0, x1; };

__device__ __forceinline__ int xcd_remap(int L, int nwg) { const int q = nwg / NXCD, r = nwg % NXCD, xcd = L % NXCD, off = L / NXCD; return (xcd < r ? xcd * (q + 1) : r * (q + 1) + (xcd - r) * q) + off; }

struct DenseOrder {
    static constexpr bool GATHER = false;
    const bf16_t* A; const bf16_t* Bt; int ldA, ldB; int nM, nN, nwg, G, c;
    __device__ void init(const bf16_t* A_, const bf16_t* Bt_, int M_, int N_, int ldA_, int ldB_, int G_, int c_) { A = A_; Bt = Bt_; ldA = ldA_; ldB = ldB_; nM = M_ / BM; nN = N_ / BM; nwg = nM * nN; G = G_; c = c_; }
    __device__ __forceinline__ bool next(int i, Unit& u) const {
        const long L = (long)i * G + c; if (L >= nwg) return false;
        const int wgid = xcd_remap((int)L, nwg);
        const int nig = WGM * nN, gid = wgid / nig, fm = gid * WGM, gsz = (nM - fm) < WGM ? (nM - fm) : WGM;
        u.pm = fm + ((wgid % nig) % gsz); u.pn = (wgid % nig) / gsz; u.x0 = 0; u.x1 = 0; return true;
    }
    __device__ __forceinline__ const char* a_base(const Unit& u) const { return (const char*)A + (size_t)u.pm * BM * ldA * 2; }
    __device__ __forceinline__ void a_voff(const Unit&, const int (&R)[2], const int (&C)[2], unsigned (&v)[2][2]) const {
#pragma unroll
        for (int h = 0; h < 2; ++h)
#pragma unroll
            for (int i = 0; i < 2; ++i) v[h][i] = (unsigned)((h * HALF + R[i]) * ldA + C[i]) * 2u;
    }
    __device__ __forceinline__ const char* b_base(const Unit& u, int half, int kt) const { return (const char*)Bt + ((size_t)(u.pn * BM + half * HALF) * ldB + (size_t)kt * BK) * 2; }
};

__device__ __forceinline__ unsigned cvt_pk_bf16(float lo, float hi) { unsigned r; asm volatile("v_cvt_pk_bf16_f32 %0, %1, %2" : "=v"(r) : "v"(lo), "v"(hi)); return r; }

struct EpiBf16 {
    static constexpr bool PERM = true;
    bf16_t* O; int ldc;
    __device__ __forceinline__ void operator()(const f32x4 (&acc)[2][2][4][2], const Unit& u, int wr, int wc, int fr, int fq) const {
        const int row0 = u.pm * BM + wr * 64 + fr; const int col0 = u.pn * BM + wc * 32 + 8 * fq;
#pragma unroll
        for (int ai = 0; ai < 2; ++ai)
#pragma unroll
            for (int m = 0; m < 4; ++m) { bf16_t* rowp = O + (size_t)(row0 + ai * HALF + m * 16) * ldc + col0;
#pragma unroll
                for (int bj = 0; bj < 2; ++bj) { const f32x4 v0 = acc[ai][bj][m][0], v1 = acc[ai][bj][m][1];
                    u32x4 w; w.x = cvt_pk_bf16(v0[0], v0[1]); w.y = cvt_pk_bf16(v0[2], v0[3]); w.z = cvt_pk_bf16(v1[0], v1[1]); w.w = cvt_pk_bf16(v1[2], v1[3]);
                    *(u32x4*)(rowp + bj * HALF) = w; } }
    }
};
struct EpiResF32 {
    static constexpr bool PERM = false;
    const float* res; float* out; int ldc;
    __device__ __forceinline__ void operator()(const f32x4 (&acc)[2][2][4][2], const Unit& u, int wr, int wc, int fr, int fq) const {
        const int row0 = u.pm * BM + wr * 64 + fr, col0 = u.pn * BM + wc * 32 + 4 * fq;
#pragma unroll
        for (int ai = 0; ai < 2; ++ai)
#pragma unroll
            for (int m = 0; m < 4; ++m) { const size_t off = (size_t)(row0 + ai * HALF + m * 16) * ldc + col0;
#pragma unroll
                for (int bj = 0; bj < 2; ++bj)
#pragma unroll
                    for (int n = 0; n < 2; ++n) { const f32x4 r = *(const f32x4*)(res + off + bj * HALF + n * 16); *(f32x4*)(out + off + bj * HALF + n * 16) = r + acc[ai][bj][m][n]; }
                asm volatile("" ::: "memory"); }
    }
};

template <class Epi, class Sched, bool ALIGN_EPI, bool SP2>
__device__ __forceinline__ void gemm_phase(PG8_LAS unsigned char* lds, const Sched& S, const Epi& E, const int ldB, const int K) {
    const int tid = threadIdx.x, wid = __builtin_amdgcn_readfirstlane(tid >> 6), lane = tid & 63, wr = wid >> 2, wc = wid & 3, fr = lane & 15, fq = lane >> 4;
    const int nt = K / BK;
    int sR[2], sC[2]; unsigned voffB[2];
#pragma unroll
    for (int i = 0; i < 2; ++i) { stage_rc(tid * 16 + i * 8192, sR[i], sC[i]); const int Rb = Epi::PERM ? ((sR[i] & ~31) + perm32(sR[i] & 31)) : sR[i];
        voffB[i] = (unsigned)(Rb * ldB + sC[i]) * 2u; }
    const size_t kstep = (size_t)(BK * 2);
    const unsigned ldsw = (unsigned)wid * 1024u;
    const int aoff = lds_byte(wr * 64 + fr, fq * 8), boff = lds_byte(wc * 32 + fr, fq * 8);
#define PG8_SA(b, h) (((b) * 2 + (h)) * HTB)
#define PG8_SB(b, h) ((4 + (b) * 2 + (h)) * HTB)
#define PG8_STAGE(bufoff, gbase, voff) do { _Pragma("unroll") for (int _i = 0; _i < 2; ++_i) \
        __builtin_amdgcn_global_load_lds((const unsigned*)((const char*)(gbase) + (voff)[_i]), (PG8_LAS unsigned*)(lds + (bufoff) + ldsw + _i * 8192), 16, 0, 0); } while (0)
#define PG8_LDA(dst, b, h) do { _Pragma("unroll") for (int m = 0; m < 4; ++m) _Pragma("unroll") for (int k = 0; k < 2; ++k) dst[m][k] = *(const PG8_LAS bf16x8*)(lds + PG8_SA(b, h) + aoff + m * 2048 + k * 1024); } while (0)
#define PG8_LDB(dst, b, h) do { _Pragma("unroll") for (int n = 0; n < 2; ++n) _Pragma("unroll") for (int k = 0; k < 2; ++k) dst[n][k] = *(const PG8_LAS bf16x8*)(lds + PG8_SB(b, h) + boff + n * 2048 + k * 1024); } while (0)
#define PG8_MMA(ai, bj, At, Bt) do { __builtin_amdgcn_s_setprio(1); _Pragma("unroll") for (int m = 0; m < 4; ++m) _Pragma("unroll") for (int n = 0; n < 2; ++n) _Pragma("unroll") for (int k = 0; k < 2; ++k) \
        acc[ai][bj][m][n] = __builtin_amdgcn_mfma_f32_16x16x32_bf16(Bt[n][k], At[m][k], acc[ai][bj][m][n], 0, 0, 0); __builtin_amdgcn_s_setprio(0); } while (0)
#define PG8_WAIT_V(n) asm volatile("s_waitcnt vmcnt(" #n ")" ::: "memory")
#define PG8_WAIT_L(n) asm volatile("s_waitcnt lgkmcnt(" #n ")" ::: "memory")
#define PG8_BAR __builtin_amdgcn_s_barrier()
#define PG8_SCHED __builtin_amdgcn_sched_barrier(0)
    Unit cur, nxt; int ui = 0;
    if (!S.next(0, cur)) return;
    f32x4 acc[2][2][4][2];
#pragma unroll
    for (int a = 0; a < 2; ++a)
#pragma unroll
        for (int b = 0; b < 2; ++b)
#pragma unroll
            for (int m = 0; m < 4; ++m)
#pragma unroll
                for (int n = 0; n < 2; ++n) acc[a][b][m][n] = (f32x4){0.f, 0.f, 0.f, 0.f};
    bf16x8 At[4][2], B0[2][2], B1[2][2];
    unsigned vA[2][2], vN[2][2];
    S.a_voff(cur, sR, sC, vA);
    const char* cA = S.a_base(cur);
    if constexpr (SP2) {
        PG8_STAGE(PG8_SB(0, 0), S.b_base(cur, 0, 0), voffB); PG8_STAGE(PG8_SB(0, 1), S.b_base(cur, 1, 0), voffB); PG8_STAGE(PG8_SA(0, 0), cA, vA[0]); PG8_STAGE(PG8_SA(0, 1), cA, vA[1]);
        if (wr == 1) PG8_BAR;
        PG8_WAIT_V(2); PG8_BAR;
        PG8_STAGE(PG8_SB(1, 0), S.b_base(cur, 0, 1), voffB); PG8_STAGE(PG8_SA(1, 0), cA + kstep, vA[0]); PG8_STAGE(PG8_SB(1, 1), S.b_base(cur, 1, 1), voffB);
        PG8_WAIT_V(6); PG8_BAR;
    } else {
        PG8_STAGE(PG8_SB(0, 0), S.b_base(cur, 0, 0), voffB); PG8_STAGE(PG8_SA(0, 0), cA, vA[0]); PG8_STAGE(PG8_SB(0, 1), S.b_base(cur, 1, 0), voffB); PG8_STAGE(PG8_SA(0, 1), cA, vA[1]);
        if (wr == 1) PG8_BAR;
        PG8_WAIT_V(4); PG8_BAR;
        PG8_STAGE(PG8_SB(1, 0), S.b_base(cur, 0, 1), voffB); PG8_STAGE(PG8_SA(1, 0), cA + kstep, vA[0]); PG8_STAGE(PG8_SB(1, 1), S.b_base(cur, 1, 1), voffB);
        PG8_WAIT_V(6); PG8_BAR;
    }
    for (;;) {
        const bool has_next = S.next(ui + 1, nxt);
        if (!has_next) nxt = cur;
        const char* nA = S.a_base(nxt);
        if (Sched::GATHER) { S.a_voff(nxt, sR, sC, vN); }
        else {
#pragma unroll
            for (int h = 0; h < 2; ++h)
#pragma unroll
                for (int i = 0; i < 2; ++i) vN[h][i] = vA[h][i]; }
        for (int t = 0; t < nt; t += 2) {
            const bool last = (t == nt - 2);
            const char* a1 = cA + (size_t)(t + 1) * kstep;
            const char* a2 = last ? nA : cA + (size_t)(t + 2) * kstep; const char* a3 = a2 + kstep;
            const Unit& bu = last ? nxt : cur; const int k2 = last ? 0 : t + 2, k3 = k2 + 1;
            const char* b20 = S.b_base(bu, 0, k2); const char* b21 = S.b_base(bu, 1, k2); const char* b30 = S.b_base(bu, 0, k3); const char* b31 = S.b_base(bu, 1, k3);
            unsigned v2[2][2];
#pragma unroll
            for (int h = 0; h < 2; ++h)
#pragma unroll
                for (int i = 0; i < 2; ++i) v2[h][i] = last ? vN[h][i] : vA[h][i];
            if constexpr (SP2) {
            PG8_LDB(B0, 0, 0); PG8_LDB(B1, 0, 1); PG8_SCHED; PG8_LDA(At, 0, 0); PG8_STAGE(PG8_SA(1, 1), a1, vA[1]);
            PG8_WAIT_V(8); PG8_WAIT_L(0); PG8_BAR; PG8_MMA(0, 0, At, B0); PG8_MMA(0, 1, At, B1); PG8_BAR; PG8_SCHED;
            PG8_LDA(At, 0, 1); PG8_STAGE(PG8_SB(0, 0), b20, voffB); PG8_STAGE(PG8_SB(0, 1), b21, voffB); PG8_STAGE(PG8_SA(0, 0), a2, v2[0]);
            PG8_WAIT_V(8); PG8_WAIT_L(0); PG8_BAR; PG8_MMA(1, 0, At, B0); PG8_MMA(1, 1, At, B1); PG8_BAR; PG8_SCHED;
            PG8_LDB(B0, 1, 0); PG8_LDB(B1, 1, 1); PG8_SCHED; PG8_LDA(At, 1, 0); PG8_STAGE(PG8_SA(0, 1), a2, v2[1]);
            PG8_WAIT_V(8); PG8_WAIT_L(0); PG8_BAR; PG8_MMA(0, 0, At, B0); PG8_MMA(0, 1, At, B1); PG8_BAR; PG8_SCHED;
            PG8_LDA(At, 1, 1); PG8_STAGE(PG8_SB(1, 0), b30, voffB); PG8_STAGE(PG8_SB(1, 1), b31, voffB); PG8_STAGE(PG8_SA(1, 0), a3, v2[0]);
            PG8_WAIT_V(8); PG8_WAIT_L(0); PG8_BAR; PG8_MMA(1, 0, At, B0); PG8_MMA(1, 1, At, B1); PG8_BAR; PG8_SCHED;
            } else {
            PG8_LDB(B0, 0, 0); PG8_SCHED; PG8_LDA(At, 0, 0); PG8_STAGE(PG8_SA(1, 1), a1, vA[1]);
            PG8_WAIT_L(8); PG8_BAR; PG8_WAIT_L(0); PG8_MMA(0, 0, At, B0); PG8_BAR; PG8_SCHED;
            PG8_LDB(B1, 0, 1); PG8_STAGE(PG8_SB(0, 0), b20, voffB);
            PG8_BAR; PG8_WAIT_L(0); PG8_MMA(0, 1, At, B1); PG8_BAR;
            PG8_LDA(At, 0, 1); PG8_STAGE(PG8_SA(0, 0), a2, v2[0]);
            PG8_BAR; PG8_WAIT_L(0); PG8_MMA(1, 0, At, B0); PG8_BAR; PG8_SCHED;
            PG8_STAGE(PG8_SB(0, 1), b21, voffB);
            PG8_WAIT_V(6); PG8_BAR; PG8_MMA(1, 1, At, B1); PG8_BAR;
            PG8_LDB(B0, 1, 0); PG8_SCHED; PG8_LDA(At, 1, 0); PG8_STAGE(PG8_SA(0, 1), a2, v2[1]);
            PG8_WAIT_L(8); PG8_BAR; PG8_WAIT_L(0); PG8_MMA(0, 0, At, B0); PG8_BAR; PG8_SCHED;
            PG8_LDB(B1, 1, 1); PG8_STAGE(PG8_SB(1, 0), b30, voffB);
            PG8_BAR; PG8_WAIT_L(0); PG8_MMA(0, 1, At, B1); PG8_BAR;
            PG8_LDA(At, 1, 1); PG8_STAGE(PG8_SA(1, 0), a3, v2[0]);
            PG8_BAR; PG8_WAIT_L(0); PG8_MMA(1, 0, At, B0); PG8_BAR; PG8_SCHED;
            PG8_STAGE(PG8_SB(1, 1), b31, voffB);
            PG8_WAIT_V(6); PG8_BAR; PG8_MMA(1, 1, At, B1); PG8_BAR;
            }
        }
        if constexpr (ALIGN_EPI) { if (wr == 0) PG8_BAR; }
        E(acc, cur, wr, wc, fr, fq);
        if (!has_next) break;
#pragma unroll
        for (int a = 0; a < 2; ++a)
#pragma unroll
            for (int b = 0; b < 2; ++b)
#pragma unroll
                for (int m = 0; m < 4; ++m)
#pragma unroll
                    for (int n = 0; n < 2; ++n) acc[a][b][m][n] = (f32x4){0.f, 0.f, 0.f, 0.f};
        cur = nxt; cA = nA; ++ui;
#pragma unroll
        for (int h = 0; h < 2; ++h)
#pragma unroll
            for (int i = 0; i < 2; ++i) vA[h][i] = vN[h][i];
        if constexpr (ALIGN_EPI) { if (wr == 1) PG8_BAR; }
    }
    PG8_WAIT_V(0);
    if constexpr (!ALIGN_EPI) { if (wr == 0) PG8_BAR; }
    PG8_BAR;
#undef PG8_SA
#undef PG8_SB
#undef PG8_STAGE
#undef PG8_LDA
#undef PG8_LDB
#undef PG8_MMA
#undef PG8_WAIT_V
#undef PG8_WAIT_L
#undef PG8_BAR
#undef PG8_SCHED
}
}

#define XB_TMO      128
#define XB_XCNT(j)  (256  + 64 * (j))
#define XB_XSUB(j)  (1280 + 64 * (j))
#define XB_XGEN(j)  (2304 + 64 * (j))
#define XB_TOP      3328
#define XB_TOPGEN   3392
#define XCD_BAR_WORDS 3456
#define XB_SPIN_CAP (1u << 18)
__device__ __forceinline__ unsigned xb_ld(unsigned* p)              { return __hip_atomic_load(p, __ATOMIC_RELAXED, __HIP_MEMORY_SCOPE_AGENT); }
__device__ __forceinline__ unsigned xb_add(unsigned* p, unsigned v) { return __hip_atomic_fetch_add(p, v, __ATOMIC_RELAXED, __HIP_MEMORY_SCOPE_AGENT); }
__device__ __forceinline__ unsigned xb_xcc_id() { return (unsigned)__builtin_amdgcn_s_getreg((3 << 11) | 20) & 0xFu; }
#define XB_SPIN(cond, bar) do { unsigned _sp = 0; while (cond) { __builtin_amdgcn_s_sleep(1); \
    if ((++_sp & 255u) == 0u) { if (xb_ld(&(bar)[XB_TMO])) break; if (_sp > XB_SPIN_CAP) { atomicAdd(&(bar)[XB_TMO], 1u); break; } } } } while (0)
struct XcdBarrier { unsigned* bar; unsigned x; volatile LAS unsigned* st; };
__device__ __forceinline__ XcdBarrier xcd_barrier_post(unsigned* bar, volatile LAS unsigned* st) {
    XcdBarrier b; b.bar = bar; b.x = xb_xcc_id(); b.st = st;
    if (threadIdx.x == 0) (void)xb_add(&bar[XB_XCNT(b.x)], 1u);
    return b;
}
__device__ __forceinline__ void xcd_barrier_complete(unsigned* bar, unsigned x, unsigned& nloc, unsigned& nx) {
    const unsigned G = gridDim.x * gridDim.y * gridDim.z;
    unsigned sum, cnt, mine, sp = 0u;
    for (;;) {
        sum = 0u; cnt = 0u; mine = 0u;
#pragma unroll
        for (unsigned j = 0; j < 16; ++j) { const unsigned c = xb_ld(&bar[XB_XCNT(j)]); sum += c; cnt += (c > 0u) ? 1u : 0u; mine = (j == x) ? c : mine; }
        if (sum == G) break;
        __builtin_amdgcn_s_sleep(1);
        if ((++sp & 255u) == 0u) { if (xb_ld(&bar[XB_TMO])) break; if (sp > XB_SPIN_CAP) { atomicAdd(&bar[XB_TMO], 1u); break; } }
    }
    nloc = mine > 0u ? mine : 1u; nx = cnt > 0u ? cnt : 1u;
}
__device__ __forceinline__ void xcd_barrier(const XcdBarrier& b) {
    asm volatile("s_waitcnt vmcnt(0)" ::: "memory");
    __syncthreads();
    if (threadIdx.x == 0) {
        unsigned* bar = b.bar;
        __builtin_amdgcn_s_waitcnt(0);
        unsigned nloc = b.st[0], nx = b.st[1];
        if (nloc == 0u) { xcd_barrier_complete(bar, b.x, nloc, nx); b.st[0] = nloc; b.st[1] = nx; }
        const unsigned old = xb_add(&bar[XB_XSUB(b.x)], 1u);
        const unsigned gen = old / nloc;
        if (old + 1u == (gen + 1u) * nloc) {
            __builtin_amdgcn_fence(__ATOMIC_RELEASE, "agent");
            asm volatile("s_waitcnt vmcnt(0)" ::: "memory");
            const unsigned og = xb_add(&bar[XB_TOP], 1u);
            const unsigned tg = og / nx;
            if (og + 1u == (tg + 1u) * nx) xb_add(&bar[XB_TOPGEN], 1u);
            else XB_SPIN(xb_ld(&bar[XB_TOPGEN]) == tg, bar);
            __builtin_amdgcn_fence(__ATOMIC_ACQUIRE, "agent");
            xb_add(&bar[XB_XGEN(b.x)], 1u);
            asm volatile("s_waitcnt vmcnt(0)" ::: "memory");
        } else {
            XB_SPIN(xb_ld(&bar[XB_XGEN(b.x)]) == gen, bar);
            __builtin_amdgcn_fence(__ATOMIC_ACQUIRE, "agent");
            asm volatile("s_waitcnt vmcnt(0)" ::: "memory");
        }
    }
    __syncthreads();
}

struct Frame {
    LAS unsigned char* lds;
    volatile LAS unsigned* MISC;
    gu32* ctl;
    int tid, lane, wave, vcu, G;
    unsigned char* ws; float* out;
    const float *x, *w_in, *w_out, *g_mix, *g_ffn, *g_fin, *g_att, *rel_bias, *dec_f, *dec_b, *rgw, *rgb, *rew, *reb, *w1, *w3, *w2;
    bf16 *WinT, *WoutT, *W1T, *W3T, *W2T, *XN, *PROJ, *MIX, *HID;
    float *COS, *SIN, *BIAS, *KV;
    bf16* ATTO; float* ATTL;
    ListEnt* LIST;
};

__device__ __forceinline__ void p0_transpose_item(const float* W, int K, int N, bf16* WT, int row_off, LAS float* scr, int item, int lane, const float* ksc, int klim, float csc) {
    const int nblk = N / 32, kb = item / nblk, nb = item % nblk, k0 = 64 * kb, n0 = 32 * nb;
#pragma unroll 8
    for (int i = 0; i < 32; ++i) { const int kk = 2 * i + (lane >> 5); const int k = k0 + kk; float s = csc; if (ksc && k < klim) s *= ksc[k];
        scr[kk * 33 + (lane & 31)] = W[(size_t)k * N + n0 + (lane & 31)] * s; }
    LDS_WAIT(); asm volatile("" ::: "memory");
    const int c = lane & 7;
#pragma unroll
    for (int j = 0; j < 4; ++j) { const int n = (lane >> 3) + 8 * j; const LAS float* s = scr + (8 * c) * 33 + n;
        v4u o; o.x = pk2(s[0 * 33], s[1 * 33]); o.y = pk2(s[2 * 33], s[3 * 33]); o.z = pk2(s[4 * 33], s[5 * 33]); o.w = pk2(s[6 * 33], s[7 * 33]);
        *(GAS v4u*)(WT + (size_t)(row_off + n0 + n) * K + k0 + 8 * c) = o; }
    LDS_WAIT(); asm volatile("" ::: "memory");
}
__device__ __forceinline__ int t5_bucket(int rel) {
    const int n = rel < 0 ? -rel : rel; const int off = rel > 0 ? 16 : 0;
    if (n < 8) return off + n;
    int large = 8 + (int)(logf((float)n / 8.0f) / logf(128.0f) * 8.0f);
    if (large > 15) large = 15;
    return off + large;
}
__device__ __forceinline__ void p0_prologue(Frame& F) {
    LAS float* scr = (LAS float*)(F.lds + RING_OFF + F.wave * 16384);
    const int gw = F.vcu * NWAVES + F.wave, NGW = F.G * NWAVES;
    constexpr int I_IN = (D / 64) * (PW / 32), I_OUT = (D / 64) * (D / 32), I_UP = (D / 64) * (FF / 32), I_DN = (FF / 64) * (D / 32);
    constexpr int NITEMS = I_IN + I_OUT + NE * (2 * I_UP + I_DN);
    for (int it = gw; it < NITEMS; it += NGW) {
        int r = it;
        if (r < I_IN) { const int n0 = 32 * (r % (PW / 32)); const float csc = (n0 < C_AK || (n0 >= C_RK && n0 < C_RV)) ? 0.125f : 1.0f;
            p0_transpose_item(F.w_in, D, PW, F.WinT, 0, scr, r, F.lane, F.g_mix, D, csc); continue; } r -= I_IN;
        if (r < I_OUT) { p0_transpose_item(F.w_out, D, D, F.WoutT, 0, scr, r, F.lane, F.g_att, 512, 1.0f); continue; } r -= I_OUT;
        const int e = r / (2 * I_UP + I_DN); r -= e * (2 * I_UP + I_DN);
        if (r < I_UP) { p0_transpose_item(F.w1 + (size_t)e * D * FF, D, FF, F.W1T + (size_t)e * FF * D, 0, scr, r, F.lane, F.g_ffn, D, 1.0f); continue; } r -= I_UP;
        if (r < I_UP) { p0_transpose_item(F.w3 + (size_t)e * D * FF, D, FF, F.W3T + (size_t)e * FF * D, 0, scr, r, F.lane, F.g_ffn, D, 1.0f); continue; } r -= I_UP;
        p0_transpose_item(F.w2 + (size_t)e * FF * D, FF, D, F.W2T + (size_t)e * D * FF, 0, scr, r, F.lane, nullptr, 0, 1.0f);
    }
    for (int m = gw; m < M; m += NGW) {
        const GAS f32x4* xr = (const GAS f32x4*)(F.x + (size_t)m * D) + F.lane;
        f32x4 v[4]; float s = 0.f;
#pragma unroll
        for (int j = 0; j < 4; ++j) { v[j] = xr[64 * j]; s += (v[j].x * v[j].x + v[j].y * v[j].y) + (v[j].z * v[j].z + v[j].w * v[j].w); }
        const float rstd = 1.f / sqrtf(wave_sum(s) * (1.f / D) + EPS);
        GAS unsigned long long* o8 = (GAS unsigned long long*)(F.XN + (size_t)m * D) + F.lane;
#pragma unroll
        for (int j = 0; j < 4; ++j) o8[64 * j] = (unsigned long long)pk2(v[j].x * rstd, v[j].y * rstd) | ((unsigned long long)pk2(v[j].z * rstd, v[j].w * rstd) << 32);
    }
    const int gt = F.vcu * 512 + F.tid, NGT = F.G * 512;
    for (int i = gt; i < SEQ * 32; i += NGT) {
        const int pos = i >> 5, fi = i & 31;
        const float inv = powf(10000.0f, -(float)fi / 32.0f);
        const float ang = (float)pos * inv;
        const double a = (double)ang; const double k = rint(a * 0.15915494309189535); const double rr = a - k * 6.283185307179586477;
        F.COS[i] = (float)cos(rr); F.SIN[i] = (float)sin(rr);
    }
    for (int i = gt; i < 3 * NH * 132; i += NGT) {
        const int dl = i % 132, h = (i / 132) % NH, br = i / (132 * NH); const int d = br == 0 ? 1 : (br == 1 ? 4 : 16);
        float v = 0.f; if (dl <= 128) v = F.rel_bias[t5_bucket((dl - 64) * d) * NH + h];
        F.BIAS[i] = v;
    }
}

__device__ __forceinline__ void rotary_inplace(Frame& F) {
    const long gt = (long)F.vcu * 512 + F.tid, NGT = (long)F.G * 512;
    const long total = (long)M * 2 * NH * 8;
    for (long u = gt; u < total; u += NGT) {
        const int g4 = (int)(u & 7), h = (int)((u >> 3) & 7), qk = (int)((u >> 6) & 1); const int tok = (int)(u >> 7);
        const int pos = tok & (SEQ - 1);
        bf16* base = F.PROJ + (size_t)tok * PW + (qk ? C_RK : C_RQ) + h * HD + 4 * g4;
        const v2u a = *(const v2u*)base, b = *(const v2u*)(base + 32);
        const f32x4 c = *(const f32x4*)(F.COS + pos * 32 + 4 * g4), s = *(const f32x4*)(F.SIN + pos * 32 + 4 * g4);
        const float t1[4] = {bf_lo(a.x), bf_hi(a.x), bf_lo(a.y), bf_hi(a.y)}, t2[4] = {bf_lo(b.x), bf_hi(b.x), bf_lo(b.y), bf_hi(b.y)};
        float o1[4], o2[4];
#pragma unroll
        for (int j = 0; j < 4; ++j) { o1[j] = t1[j] * c[j] - t2[j] * s[j]; o2[j] = t1[j] * s[j] + t2[j] * c[j]; }
        v2u wa, wb; wa.x = pk2(o1[0], o1[1]); wa.y = pk2(o1[2], o1[3]); wb.x = pk2(o2[0], o2[1]); wb.y = pk2(o2[2], o2[3]);
        *(v2u*)base = wa; *(v2u*)(base + 32) = wb;
    }
}
__device__ __forceinline__ void load_row64(const bf16* p, float (&v)[64]) {
#pragma unroll
    for (int c = 0; c < 8; ++c) { const v4u w = *(const v4u*)(p + 8 * c);
        v[8 * c + 0] = bf_lo(w.x); v[8 * c + 1] = bf_hi(w.x); v[8 * c + 2] = bf_lo(w.y); v[8 * c + 3] = bf_hi(w.y);
        v[8 * c + 4] = bf_lo(w.z); v[8 * c + 5] = bf_hi(w.z); v[8 * c + 6] = bf_lo(w.w); v[8 * c + 7] = bf_hi(w.w); }
}
__device__ __forceinline__ void attn_naive(Frame& F) {
    const long gt = (long)F.vcu * 512 + F.tid, NGT = (long)F.G * 512;
    const long total = 3L * NB * NH * SEQ;
    for (long u = gt; u < total; u += NGT) {
        const int p = (int)(u & (SEQ - 1)), h = (int)((u >> 11) & 7), b = (int)((u >> 14) & 7), br = (int)(u >> 17);
        const int sh = 2 * br, d = 1 << sh, r = p & (d - 1), a = p >> sh, L = SEQ >> sh;
        float q[64]; load_row64(F.PROJ + (size_t)(b * SEQ + p) * PW + C_AQ + h * HD, q);
        float acc[64];
#pragma unroll
        for (int i = 0; i < 64; ++i) acc[i] = 0.f;
        float mx = -1e30f, l = 0.f;
        const int j0 = a - 64 < 0 ? 0 : a - 64, j1 = a + 64 > L - 1 ? L - 1 : a + 64;
        const float* bias = F.BIAS + (br * NH + h) * 132 + 64;
        for (int j = j0; j <= j1; ++j) {
            const size_t row = (size_t)(b * SEQ + (j << sh) + r) * PW;
            float kv[64]; load_row64(F.PROJ + row + C_AK + h * HD, kv);
            float s = 0.f;
#pragma unroll
            for (int i = 0; i < 64; ++i) s += q[i] * kv[i];
            s += bias[j - a];
            const float mn = fmaxf(mx, s), sc = __expf(mx - mn), pp = __expf(s - mn);
            load_row64(F.PROJ + row + C_AV + h * HD, kv);
            l = l * sc + pp;
#pragma unroll
            for (int i = 0; i < 64; ++i) acc[i] = acc[i] * sc + pp * kv[i];
            mx = mn;
        }
        const float il = 1.f / l;
        bf16* o = F.ATTO + ((size_t)br * M + (size_t)(b * SEQ + p)) * 512 + h * HD;
#pragma unroll
        for (int c = 0; c < 8; ++c) { v4u w; w.x = pk2(acc[8 * c] * il, acc[8 * c + 1] * il); w.y = pk2(acc[8 * c + 2] * il, acc[8 * c + 3] * il);
            w.z = pk2(acc[8 * c + 4] * il, acc[8 * c + 5] * il); w.w = pk2(acc[8 * c + 6] * il, acc[8 * c + 7] * il); *(v4u*)(o + 8 * c) = w; }
        F.ATTL[((size_t)br * M + (size_t)(b * SEQ + p)) * NH + h] = mx + __logf(l);
    }
}

namespace mx {
typedef float f32x16 __attribute__((ext_vector_type(16)));
typedef short s16x4 __attribute__((ext_vector_type(4)));
typedef short v4i16_t __attribute__((ext_vector_type(4)));
typedef __bf16 bf16x2_t __attribute__((ext_vector_type(2)));
__device__ __forceinline__ unsigned cvtpk(float lo, float hi) { f32x2 v = {lo, hi}; bf16x2_t b = __builtin_convertvector(v, bf16x2_t); return __builtin_bit_cast(unsigned, b); }
__device__ __forceinline__ s16x4 vtr(const LAS unsigned char* p) { return __builtin_bit_cast(s16x4, __builtin_amdgcn_ds_read_tr16_b64_v4i16((LAS v4i16_t*)p)); }
__device__ __forceinline__ int crow(int r, int hi) { return (r & 3) + 8 * (r >> 2) + 4 * hi; }
__device__ __forceinline__ int k_off(int row, int ch) { return row * 128 + ((ch ^ ((row >> 1) & 7)) << 4); }
__device__ __forceinline__ int v_off(int row, int ch) { return ((row >> 3) * 2 + (ch >> 2)) * 512 + (row & 7) * 64 + (ch & 3) * 16; }
#define MFMA32(a, b, c) __builtin_amdgcn_mfma_f32_32x32x16_bf16((a), (b), (c), 0, 0, 0)
constexpr float LOG2E = 1.4426950408889634f, LN2 = 0.6931471805599453f;

constexpr int AT_K = 0, AT_V = 49152, AT_B = 98304;
constexpr int AT_UNITS = NB * NH * 24;
__device__ __forceinline__ void attn_unit(Frame& F, int u) {
    const int sub = u & 7, br = (u >> 3) % 3, bh = u / 24, b = bh >> 3, h = bh & 7;
    const int sh = 2 * br, L = SEQ >> sh;
    int r0, r1, q0, kbase, nk, nrows;
    if (br < 2) { r0 = (br == 0) ? 0 : (sub >> 1); r1 = r0; q0 = (br == 0) ? sub * 256 : (sub & 1) * 256; kbase = q0 - 64 < 0 ? 0 : q0 - 64; const int kend = q0 + 320 > L ? L : q0 + 320; nk = kend - kbase; nrows = nk; }
    else { r0 = 2 * sub; r1 = r0 + 1; q0 = 0; kbase = 0; nk = 128; nrows = 256; }
    LAS unsigned char* lds = F.lds;
    __syncthreads();
    {
        v4u kr[6], vr[6];
#pragma unroll
        for (int it = 0; it < 6; ++it) { const int c = F.tid + 512 * it, row = c >> 3, ch = c & 7;
            if (row < nrows) { const int seg = (br == 2) ? (row >> 7) : 0, li = row - seg * nk; const int tok = b * SEQ + ((kbase + li) << sh) + (seg ? r1 : r0);
                const bf16* p = F.PROJ + (size_t)tok * PW + h * HD + ch * 8; kr[it] = *(const v4u*)(p + C_AK); vr[it] = *(const v4u*)(p + C_AV); } }
#pragma unroll
        for (int it = 0; it < 6; ++it) { const int c = F.tid + 512 * it, row = c >> 3, ch = c & 7;
            if (row < nrows) { *(LAS v4u*)(lds + AT_K + k_off(row, ch)) = kr[it]; *(LAS v4u*)(lds + AT_V + v_off(row, ch)) = vr[it]; } }
        if (F.tid < 192) { const int dl = F.tid - 32; float v = 0.f; if (dl >= 0 && dl <= 128) v = F.BIAS[(br * NH + h) * 132 + dl]; ((LAS float*)(lds + AT_B))[F.tid] = v * LOG2E; }
    }
    const int w = F.wave, lane = F.lane, qc = lane & 31, hh = lane >> 5;
    const int seg = (br == 2) ? (w >> 2) : 0, qs = (br == 2) ? 32 * (w & 3) : q0 + 32 * w;
    const int tq = b * SEQ + ((qs + qc) << sh) + (seg ? r1 : r0);
    bf16x8 qf[4];
    { const bf16* qp = F.PROJ + (size_t)tq * PW + C_AQ + h * HD + 8 * hh;
#pragma unroll
      for (int s = 0; s < 4; ++s) qf[s] = *(const bf16x8*)(qp + 16 * s); }
    LDS_WAIT(); __syncthreads();
    f32x16 S[5];
    bool valid[5];
    const LAS float* bl = (const LAS float*)(lds + AT_B);
#pragma unroll
    for (int t = 0; t < 5; ++t) {
        const int kp = qs + 32 * (t - 2); valid[t] = (kp >= 0) && (kp < L);
        const int R0 = seg * nk + (kp - kbase);
#pragma unroll
        for (int i = 0; i < 16; ++i) S[t][i] = 0.f;
        if (valid[t]) {
#pragma unroll
            for (int s = 0; s < 4; ++s) { const bf16x8 a = *(const LAS bf16x8*)(lds + AT_K + k_off(R0 + qc, 2 * s + hh)); S[t] = MFMA32(a, qf[s], S[t]); }
#pragma unroll
            for (int i = 0; i < 16; ++i) { const int kr = crow(i, hh); const int rel = 32 * (t - 2) + kr - qc; float v = S[t][i] * LOG2E + bl[rel + 96];
                if (t == 0 && kr < qc) v = -1e30f; if (t == 4 && kr > qc) v = -1e30f; S[t][i] = v; }
        } else {
#pragma unroll
            for (int i = 0; i < 16; ++i) S[t][i] = -1e30f;
        }
    }
    float mx = -1e30f;
#pragma unroll
    for (int t = 0; t < 5; ++t)
#pragma unroll
        for (int i = 0; i < 16; ++i) mx = fmaxf(mx, S[t][i]);
    mx = fmaxf(mx, __shfl_xor(mx, 32));
    float l = 0.f;
#pragma unroll
    for (int t = 0; t < 5; ++t)
#pragma unroll
        for (int i = 0; i < 16; ++i) { const float p = __builtin_amdgcn_exp2f(S[t][i] - mx); S[t][i] = p; l += p; }
    l += __shfl_xor(l, 32);
    f32x16 O[2];
#pragma unroll
    for (int i = 0; i < 16; ++i) { O[0][i] = 0.f; O[1][i] = 0.f; }
    const int i16 = lane & 15, q4 = i16 >> 2, p4 = i16 & 3, blk = (lane >> 4) & 1;
#pragma unroll
    for (int t = 0; t < 5; ++t) {
        if (valid[t]) {
            const int R0 = seg * nk + (qs + 32 * (t - 2) - kbase);
#pragma unroll
            for (int s2 = 0; s2 < 2; ++s2) {
                v4u pw; pw.x = cvtpk(S[t][8 * s2 + 0], S[t][8 * s2 + 1]); pw.y = cvtpk(S[t][8 * s2 + 2], S[t][8 * s2 + 3]); pw.z = cvtpk(S[t][8 * s2 + 4], S[t][8 * s2 + 5]); pw.w = cvtpk(S[t][8 * s2 + 6], S[t][8 * s2 + 7]);
                const bf16x8 pb = __builtin_bit_cast(bf16x8, pw);
                const int rlo = R0 + 16 * s2 + 4 * hh + q4;
#pragma unroll
                for (int dt = 0; dt < 2; ++dt) {
                    const int ch = 4 * dt + 2 * blk + (p4 >> 1);
                    const s16x4 lo = vtr(lds + AT_V + v_off(rlo, ch) + (p4 & 1) * 8), hi = vtr(lds + AT_V + v_off(rlo + 8, ch) + (p4 & 1) * 8);
                    const bf16x8 va = __builtin_shufflevector(lo, hi, 0, 1, 2, 3, 4, 5, 6, 7);
                    O[dt] = MFMA32(va, pb, O[dt]);
                }
            }
        }
    }
    const float il = 1.f / l;
    bf16* op = F.ATTO + ((size_t)br * M + tq) * 512 + h * HD + 4 * hh;
#pragma unroll
    for (int dt = 0; dt < 2; ++dt)
#pragma unroll
        for (int g = 0; g < 4; ++g) { v2u wv; wv.x = cvtpk(O[dt][4 * g] * il, O[dt][4 * g + 1] * il); wv.y = cvtpk(O[dt][4 * g + 2] * il, O[dt][4 * g + 3] * il); *(v2u*)(op + 32 * dt + 8 * g) = wv; }
    if (hh == 0) F.ATTL[((size_t)br * M + tq) * NH + h] = (mx + __builtin_amdgcn_logf(l)) * LN2;
}
__device__ __forceinline__ void attn_phase(Frame& F) {
    for (int u = F.vcu; u < AT_UNITS; u += F.G) attn_unit(F, u);
    __syncthreads();
}

__device__ __forceinline__ void load_rot8(const Frame& F, const bf16* p, int pos, int ch, float (&o1)[8], float (&o2)[8]) {
    const v4u a = *(const v4u*)(p + 8 * ch), b = *(const v4u*)(p + 32 + 8 * ch);
    const f32x4 c0 = *(const f32x4*)(F.COS + pos * 32 + 8 * ch), c1 = *(const f32x4*)(F.COS + pos * 32 + 8 * ch + 4);
    const f32x4 s0 = *(const f32x4*)(F.SIN + pos * 32 + 8 * ch), s1 = *(const f32x4*)(F.SIN + pos * 32 + 8 * ch + 4);
    const float t1[8] = {bf_lo(a.x), bf_hi(a.x), bf_lo(a.y), bf_hi(a.y), bf_lo(a.z), bf_hi(a.z), bf_lo(a.w), bf_hi(a.w)};
    const float t2[8] = {bf_lo(b.x), bf_hi(b.x), bf_lo(b.y), bf_hi(b.y), bf_lo(b.z), bf_hi(b.z), bf_lo(b.w), bf_hi(b.w)};
    const float cs[8] = {c0.x, c0.y, c0.z, c0.w, c1.x, c1.y, c1.z, c1.w}, sn[8] = {s0.x, s0.y, s0.z, s0.w, s1.x, s1.y, s1.z, s1.w};
#pragma unroll
    for (int j = 0; j < 8; ++j) { o1[j] = t1[j] * cs[j] - t2[j] * sn[j]; o2[j] = t1[j] * sn[j] + t2[j] * cs[j]; }
}
__device__ __forceinline__ v4u pack8(const float (&o)[8], float s) { v4u w; w.x = cvtpk(o[0] * s, o[1] * s); w.y = cvtpk(o[2] * s, o[3] * s); w.z = cvtpk(o[4] * s, o[5] * s); w.w = cvtpk(o[6] * s, o[7] * s); return w; }
constexpr int R1_UNITS = NB * NH * NCH;
__device__ __forceinline__ void ret_kv_unit(Frame& F, int u) {
    const int c = u & (NCH - 1), bh = u >> 4, b = bh >> 3, h = bh & 7;
    const float lgf = -__expf(F.dec_f[h]) * LOG2E, lgb = -__expf(F.dec_b[h]) * LOG2E;
    LAS unsigned char* lds = F.lds;
    __syncthreads();
    { const int row = F.tid >> 2, ch = F.tid & 3; const int pos = c * RC + row, tok = b * SEQ + pos;
      const bf16* p = F.PROJ + (size_t)tok * PW + h * HD;
      float o1[8], o2[8]; load_rot8(F, p + C_RK, pos, ch, o1, o2);
      const v4u va = *(const v4u*)(p + C_RV + 8 * ch), vb = *(const v4u*)(p + C_RV + 32 + 8 * ch);
      const float df = __builtin_amdgcn_exp2f(lgf * (float)(RC - 1 - row)), db = __builtin_amdgcn_exp2f(lgb * (float)row);
      *(LAS v4u*)(lds + 0 + v_off(row, ch)) = pack8(o1, df); *(LAS v4u*)(lds + 0 + v_off(row, ch + 4)) = pack8(o2, df);
      *(LAS v4u*)(lds + 16384 + v_off(row, ch)) = pack8(o1, db); *(LAS v4u*)(lds + 16384 + v_off(row, ch + 4)) = pack8(o2, db);
      *(LAS v4u*)(lds + 32768 + v_off(row, ch)) = va; *(LAS v4u*)(lds + 32768 + v_off(row, ch + 4)) = vb; }
    LDS_WAIT(); __syncthreads();
    const int w = F.wave, lane = F.lane, hh = lane >> 5, dir = w >> 2, mt = (w >> 1) & 1, nt = w & 1;
    const int i16 = lane & 15, q4 = i16 >> 2, p4 = i16 & 3, blk = (lane >> 4) & 1;
    f32x16 acc;
#pragma unroll
    for (int i = 0; i < 16; ++i) acc[i] = 0.f;
    const LAS unsigned char* kim = lds + dir * 16384; const LAS unsigned char* vim = lds + 32768;
#pragma unroll
    for (int s = 0; s < 8; ++s) {
        const int rlo = 16 * s + 8 * hh + q4;
        const int cha = 4 * mt + 2 * blk + (p4 >> 1), chb = 4 * nt + 2 * blk + (p4 >> 1);
        const s16x4 alo = vtr(kim + v_off(rlo, cha) + (p4 & 1) * 8), ahi = vtr(kim + v_off(rlo + 4, cha) + (p4 & 1) * 8);
        const s16x4 blo = vtr(vim + v_off(rlo, chb) + (p4 & 1) * 8), bhi = vtr(vim + v_off(rlo + 4, chb) + (p4 & 1) * 8);
        acc = MFMA32(__builtin_shufflevector(alo, ahi, 0, 1, 2, 3, 4, 5, 6, 7), __builtin_shufflevector(blo, bhi, 0, 1, 2, 3, 4, 5, 6, 7), acc);
    }
    float* o = F.KV + ((size_t)(u * 2 + dir)) * 4096 + (32 * mt) * 64 + 32 * nt + (lane & 31);
#pragma unroll
    for (int i = 0; i < 16; ++i) o[crow(i, hh) * 64] = acc[i];
}
constexpr int R2_UNITS = NB * NH * (NCH / 2);
constexpr int R2_CH = 49152, R2_K = 0, R2_V = 16384, R2_SF = 32768, R2_SB = 40960;
__device__ __forceinline__ void ret_out_unit(Frame& F, int u) {
    const int cp = u & 7, bh = u >> 3, b = bh >> 3, h = bh & 7, c0 = 2 * cp, c1 = c0 + 1;
    const float lgf = -__expf(F.dec_f[h]) * LOG2E, lgb = -__expf(F.dec_b[h]) * LOG2E;
    LAS unsigned char* lds = F.lds;
    __syncthreads();
#pragma unroll
    for (int j = 0; j < 2; ++j) { const int row = F.tid >> 2, ch = F.tid & 3; const int pos = (c0 + j) * RC + row, tok = b * SEQ + pos;
        const bf16* p = F.PROJ + (size_t)tok * PW + h * HD;
        float o1[8], o2[8]; load_rot8(F, p + C_RK, pos, ch, o1, o2);
        const v4u va = *(const v4u*)(p + C_RV + 8 * ch), vb = *(const v4u*)(p + C_RV + 32 + 8 * ch);
        LAS unsigned char* cb = lds + j * R2_CH;
        *(LAS v4u*)(cb + R2_K + k_off(row, ch)) = pack8(o1, 1.f); *(LAS v4u*)(cb + R2_K + k_off(row, ch + 4)) = pack8(o2, 1.f);
        *(LAS v4u*)(cb + R2_V + v_off(row, ch)) = va; *(LAS v4u*)(cb + R2_V + v_off(row, ch + 4)) = vb; }
    { const int dk = F.tid >> 3, dv8 = (F.tid & 7) * 8;
      const float* kvb = F.KV + (size_t)(bh * NCH) * 2 * 4096 + dk * 64 + dv8;
      float sf[8], sb[8];
#pragma unroll
      for (int e = 0; e < 8; ++e) { sf[e] = 0.f; sb[e] = 0.f; }
      for (int cc = 0; cc < c0; ++cc) { const float wgt = __builtin_amdgcn_exp2f(lgf * (float)(RC * (c0 - 1 - cc))); const float* q = kvb + (size_t)(cc * 2 + 0) * 4096;
          const f32x4 a = *(const f32x4*)q, bq = *(const f32x4*)(q + 4);
          sf[0] += wgt * a.x; sf[1] += wgt * a.y; sf[2] += wgt * a.z; sf[3] += wgt * a.w; sf[4] += wgt * bq.x; sf[5] += wgt * bq.y; sf[6] += wgt * bq.z; sf[7] += wgt * bq.w; }
      for (int cc = c1 + 1; cc < NCH; ++cc) { const float wgt = __builtin_amdgcn_exp2f(lgb * (float)(RC * (cc - c1 - 1))); const float* q = kvb + (size_t)(cc * 2 + 1) * 4096;
          const f32x4 a = *(const f32x4*)q, bq = *(const f32x4*)(q + 4);
          sb[0] += wgt * a.x; sb[1] += wgt * a.y; sb[2] += wgt * a.z; sb[3] += wgt * a.w; sb[4] += wgt * bq.x; sb[5] += wgt * bq.y; sb[6] += wgt * bq.z; sb[7] += wgt * bq.w; }
      float sf1[8], sb0[8];
      { const float gf = __builtin_amdgcn_exp2f(lgf * (float)RC), gb = __builtin_amdgcn_exp2f(lgb * (float)RC);
        const float* qf_ = kvb + (size_t)(c0 * 2 + 0) * 4096; const float* qb_ = kvb + (size_t)(c1 * 2 + 1) * 4096;
        const f32x4 a = *(const f32x4*)qf_, a2 = *(const f32x4*)(qf_ + 4), c = *(const f32x4*)qb_, c2 = *(const f32x4*)(qb_ + 4);
        const float kf[8] = {a.x, a.y, a.z, a.w, a2.x, a2.y, a2.z, a2.w}, kb[8] = {c.x, c.y, c.z, c.w, c2.x, c2.y, c2.z, c2.w};
#pragma unroll
        for (int e = 0; e < 8; ++e) { sf1[e] = gf * sf[e] + kf[e]; sb0[e] = gb * sb[e] + kb[e]; } }
      const int cho = (dk >> 3), bo = (dk & 7) * 2;
#pragma unroll
      for (int e = 0; e < 8; ++e) { const int dv = dv8 + e; const int off = k_off(dv, cho) + bo;
          *(LAS unsigned short*)(lds + 0 * R2_CH + R2_SF + off) = (unsigned short)f2bf(sf[e]);  *(LAS unsigned short*)(lds + 0 * R2_CH + R2_SB + off) = (unsigned short)f2bf(sb0[e]);
          *(LAS unsigned short*)(lds + 1 * R2_CH + R2_SF + off) = (unsigned short)f2bf(sf1[e]); *(LAS unsigned short*)(lds + 1 * R2_CH + R2_SB + off) = (unsigned short)f2bf(sb[e]); }
    }
    const int w = F.wave, lane = F.lane, qc = lane & 31, hh = lane >> 5, j = w >> 2, qt = w & 3;
    const int n = 32 * qt + qc, pos = (c0 + j) * RC + n, tok = b * SEQ + pos;
    bf16x8 qf[4];
    { const bf16* qp = F.PROJ + (size_t)tok * PW + C_RQ + h * HD + 8 * hh;
      v4u raw[4];
#pragma unroll
      for (int s = 0; s < 4; ++s) raw[s] = *(const v4u*)(qp + 16 * s);
#pragma unroll
      for (int s = 0; s < 2; ++s) {
          const float* cp_ = F.COS + pos * 32 + 16 * s + 8 * hh; const float* sp_ = F.SIN + pos * 32 + 16 * s + 8 * hh;
          const f32x4 cA = *(const f32x4*)cp_, cB = *(const f32x4*)(cp_ + 4), sA = *(const f32x4*)sp_, sB = *(const f32x4*)(sp_ + 4);
          const float cs[8] = {cA.x, cA.y, cA.z, cA.w, cB.x, cB.y, cB.z, cB.w}, sn[8] = {sA.x, sA.y, sA.z, sA.w, sB.x, sB.y, sB.z, sB.w};
          const v4u a = raw[s], bq = raw[s + 2];
          const float t1[8] = {bf_lo(a.x), bf_hi(a.x), bf_lo(a.y), bf_hi(a.y), bf_lo(a.z), bf_hi(a.z), bf_lo(a.w), bf_hi(a.w)};
          const float t2[8] = {bf_lo(bq.x), bf_hi(bq.x), bf_lo(bq.y), bf_hi(bq.y), bf_lo(bq.z), bf_hi(bq.z), bf_lo(bq.w), bf_hi(bq.w)};
          float o1[8], o2[8];
#pragma unroll
          for (int e = 0; e < 8; ++e) { o1[e] = t1[e] * cs[e] - t2[e] * sn[e]; o2[e] = t1[e] * sn[e] + t2[e] * cs[e]; }
          qf[s] = __builtin_bit_cast(bf16x8, pack8(o1, 1.f)); qf[s + 2] = __builtin_bit_cast(bf16x8, pack8(o2, 1.f)); } }
    LDS_WAIT(); __syncthreads();
    const LAS unsigned char* cb = lds + j * R2_CH;
    f32x16 Y[2];
#pragma unroll
    for (int i = 0; i < 16; ++i) { Y[0][i] = 0.f; Y[1][i] = 0.f; }
    const int i16 = lane & 15, q4 = i16 >> 2, p4 = i16 & 3, blk = (lane >> 4) & 1;
#pragma unroll
    for (int t = 0; t < 4; ++t) {
        f32x16 S;
#pragma unroll
        for (int i = 0; i < 16; ++i) S[i] = 0.f;
#pragma unroll
        for (int s = 0; s < 4; ++s) { const bf16x8 a = *(const LAS bf16x8*)(cb + R2_K + k_off(32 * t + qc, 2 * s + hh)); S = MFMA32(a, qf[s], S); }
#pragma unroll
        for (int i = 0; i < 16; ++i) { const int m = 32 * t + crow(i, hh); const int dd = n - m;
            const float dec = __builtin_amdgcn_exp2f((dd >= 0 ? lgf : -lgb) * (float)dd); S[i] *= dec; }
#pragma unroll
        for (int s2 = 0; s2 < 2; ++s2) {
            v4u pw; pw.x = cvtpk(S[8 * s2 + 0], S[8 * s2 + 1]); pw.y = cvtpk(S[8 * s2 + 2], S[8 * s2 + 3]); pw.z = cvtpk(S[8 * s2 + 4], S[8 * s2 + 5]); pw.w = cvtpk(S[8 * s2 + 6], S[8 * s2 + 7]);
            const bf16x8 pb = __builtin_bit_cast(bf16x8, pw);
            const int rlo = 32 * t + 16 * s2 + 4 * hh + q4;
#pragma unroll
            for (int dt = 0; dt < 2; ++dt) { const int ch = 4 * dt + 2 * blk + (p4 >> 1);
                const s16x4 lo = vtr(cb + R2_V + v_off(rlo, ch) + (p4 & 1) * 8), hi = vtr(cb + R2_V + v_off(rlo + 8, ch) + (p4 & 1) * 8);
                Y[dt] = MFMA32(__builtin_shufflevector(lo, hi, 0, 1, 2, 3, 4, 5, 6, 7), pb, Y[dt]); }
        }
        __builtin_amdgcn_sched_barrier(0);
    }
    const float qdf = __builtin_amdgcn_exp2f(lgf * (float)(n + 1)), qdb = __builtin_amdgcn_exp2f(lgb * (float)(RC - n));
#pragma unroll
    for (int dir = 0; dir < 2; ++dir) {
        const float qd = dir ? qdb : qdf;
#pragma unroll
        for (int dt = 0; dt < 2; ++dt) { f32x16 T;
#pragma unroll
            for (int i = 0; i < 16; ++i) T[i] = 0.f;
#pragma unroll
            for (int s = 0; s < 4; ++s) { const bf16x8 a = *(const LAS bf16x8*)(cb + (dir ? R2_SB : R2_SF) + k_off(32 * dt + qc, 2 * s + hh)); T = MFMA32(a, qf[s], T); }
#pragma unroll
            for (int i = 0; i < 16; ++i) Y[dt][i] += qd * T[i]; }
    }
    float ss = 0.f;
#pragma unroll
    for (int i = 0; i < 16; ++i) ss += Y[0][i] * Y[0][i] + Y[1][i] * Y[1][i];
    ss += __shfl_xor(ss, 32);
    const float rs = 1.f / sqrtf(ss * (1.f / 64.f) + EPS);
    const bf16* gp = F.PROJ + (size_t)tok * PW + C_RG + h * HD + 4 * hh;
    bf16* op = F.MIX + (size_t)tok * D + 512 + h * HD + 4 * hh;
#pragma unroll
    for (int dt = 0; dt < 2; ++dt)
#pragma unroll
        for (int g = 0; g < 4; ++g) { const v2u gw = *(const v2u*)(gp + 32 * dt + 8 * g);
            const float gg[4] = {bf_lo(gw.x), bf_hi(gw.x), bf_lo(gw.y), bf_hi(gw.y)}; float y[4];
#pragma unroll
            for (int e = 0; e < 4; ++e) y[e] = Y[dt][4 * g + e] * rs * (gg[e] / (1.f + __expf(-gg[e])));
            v2u wv; wv.x = cvtpk(y[0], y[1]); wv.y = cvtpk(y[2], y[3]); *(v2u*)(op + 32 * dt + 8 * g) = wv; }
}
__device__ __forceinline__ void ret_kv_phase(Frame& F) { for (int u = F.vcu; u < R1_UNITS; u += F.G) ret_kv_unit(F, u); __syncthreads(); }
__device__ __forceinline__ void ret_out_phase(Frame& F) { for (int u = F.vcu; u < R2_UNITS; u += F.G) ret_out_unit(F, u); __syncthreads(); }
}

__device__ __forceinline__ void ret_naive(Frame& F) {
    const long gt = (long)F.vcu * 512 + F.tid, NGT = (long)F.G * 512;
    const long total = (long)NB * NH * SEQ;
    for (long u = gt; u < total; u += NGT) {
        const int n = (int)(u & (SEQ - 1)), h = (int)((u >> 11) & 7), b = (int)(u >> 14);
        const float lgf = -__expf(F.dec_f[h]) * 1.4426950408889634f, lgb = -__expf(F.dec_b[h]) * 1.4426950408889634f;
        float q[64]; load_row64(F.PROJ + (size_t)(b * SEQ + n) * PW + C_RQ + h * HD, q);
        float acc[64];
#pragma unroll
        for (int i = 0; i < 64; ++i) acc[i] = 0.f;
        for (int m = 0; m < SEQ; ++m) {
            const size_t row = (size_t)(b * SEQ + m) * PW;
            float kv[64]; load_row64(F.PROJ + row + C_RK + h * HD, kv);
            float s = 0.f;
#pragma unroll
            for (int i = 0; i < 64; ++i) s += q[i] * kv[i];
            const float dec = (m <= n) ? exp2f(lgf * (float)(n - m)) : exp2f(lgb * (float)(m - n));
            s *= dec;
            load_row64(F.PROJ + row + C_RV + h * HD, kv);
#pragma unroll
            for (int i = 0; i < 64; ++i) acc[i] += s * kv[i];
        }
        float ss = 0.f;
#pragma unroll
        for (int i = 0; i < 64; ++i) ss += acc[i] * acc[i];
        const float rs = 1.f / sqrtf(ss * (1.f / 64.f) + EPS);
        float g[64]; load_row64(F.PROJ + (size_t)(b * SEQ + n) * PW + C_RG + h * HD, g);
        bf16* o = F.MIX + (size_t)(b * SEQ + n) * D + 512 + h * HD;
        float y[64];
#pragma unroll
        for (int i = 0; i < 64; ++i) { const float gg = g[i]; y[i] = acc[i] * rs * (gg / (1.f + __expf(-gg))); }
#pragma unroll
        for (int c = 0; c < 8; ++c) { v4u w; w.x = pk2(y[8 * c], y[8 * c + 1]); w.y = pk2(y[8 * c + 2], y[8 * c + 3]); w.z = pk2(y[8 * c + 4], y[8 * c + 5]); w.w = pk2(y[8 * c + 6], y[8 * c + 7]); *(v4u*)(o + 8 * c) = w; }
    }
}
__device__ __forceinline__ void attn_combine(Frame& F) {
    const int gw = F.vcu * NWAVES + F.wave, NGW = F.G * NWAVES;
    for (int tok = gw; tok < M; tok += NGW) {
        const int h = F.lane >> 3;
        const float l0 = F.ATTL[((size_t)0 * M + tok) * NH + h], l1 = F.ATTL[((size_t)1 * M + tok) * NH + h], l2 = F.ATTL[((size_t)2 * M + tok) * NH + h];
        const float mx = fmaxf(l0, fmaxf(l1, l2)); const float e0 = __expf(l0 - mx), e1 = __expf(l1 - mx), e2 = __expf(l2 - mx); const float inv = 1.f / (e0 + e1 + e2);
        const float w0 = e0 * inv, w1 = e1 * inv, w2 = e2 * inv;
        const v4u a = *(const v4u*)(F.ATTO + ((size_t)0 * M + tok) * 512 + 8 * F.lane), b = *(const v4u*)(F.ATTO + ((size_t)1 * M + tok) * 512 + 8 * F.lane), c = *(const v4u*)(F.ATTO + ((size_t)2 * M + tok) * 512 + 8 * F.lane);
        float o[8];
        o[0] = w0 * bf_lo(a.x) + w1 * bf_lo(b.x) + w2 * bf_lo(c.x); o[1] = w0 * bf_hi(a.x) + w1 * bf_hi(b.x) + w2 * bf_hi(c.x);
        o[2] = w0 * bf_lo(a.y) + w1 * bf_lo(b.y) + w2 * bf_lo(c.y); o[3] = w0 * bf_hi(a.y) + w1 * bf_hi(b.y) + w2 * bf_hi(c.y);
        o[4] = w0 * bf_lo(a.z) + w1 * bf_lo(b.z) + w2 * bf_lo(c.z); o[5] = w0 * bf_hi(a.z) + w1 * bf_hi(b.z) + w2 * bf_hi(c.z);
        o[6] = w0 * bf_lo(a.w) + w1 * bf_lo(b.w) + w2 * bf_lo(c.w); o[7] = w0 * bf_hi(a.w) + w1 * bf_hi(b.w) + w2 * bf_hi(c.w);
        float ss = 0.f;
#pragma unroll
        for (int i = 0; i < 8; ++i) ss += o[i] * o[i];
        const float rs = 1.f / sqrtf(wave_sum(ss) * (1.f / 512.f) + EPS);
        v4u w; w.x = pk2(o[0] * rs, o[1] * rs); w.y = pk2(o[2] * rs, o[3] * rs); w.z = pk2(o[4] * rs, o[5] * rs); w.w = pk2(o[6] * rs, o[7] * rs);
        *(v4u*)(F.MIX + (size_t)tok * D + 8 * F.lane) = w;
    }
}
__device__ __forceinline__ void router(Frame& F) {
    LAS int* s_cls = (LAS int*)(F.lds + RT_OFF); LAS float* s_glo = (LAS float*)(F.lds + RT_OFF + 256); LAS float* s_ghi = (LAS float*)(F.lds + RT_OFF + 512);
    LAS int* s_base = (LAS int*)(F.lds + RT_OFF + 768);
    const float* h1 = F.out;
    for (int blk = F.vcu; blk < M / 64; blk += F.G) {
        for (int t = 0; t < 8; ++t) {
            const int tl = F.wave * 8 + t, tok = blk * 64 + tl;
            const GAS f32x4* hr = (const GAS f32x4*)(h1 + (size_t)tok * D) + F.lane;
            f32x4 v[4]; float s = 0.f;
#pragma unroll
            for (int j = 0; j < 4; ++j) { v[j] = hr[64 * j]; s += (v[j].x * v[j].x + v[j].y * v[j].y) + (v[j].z * v[j].z + v[j].w * v[j].w); }
            const float rstd = 1.f / sqrtf(wave_sum(s) * (1.f / D) + EPS);
            GAS unsigned long long* o8 = (GAS unsigned long long*)(F.XN + (size_t)tok * D) + F.lane;
            float gl[4] = {0.f, 0.f, 0.f, 0.f};
#pragma unroll
            for (int j = 0; j < 4; ++j) { const int k = 4 * F.lane + 256 * j; v[j] = v[j] * rstd;
                o8[64 * j] = (unsigned long long)pk2(v[j].x, v[j].y) | ((unsigned long long)pk2(v[j].z, v[j].w) << 32);
                const f32x4 gn = *(const f32x4*)(F.g_ffn + k); v[j] = v[j] * gn;
#pragma unroll
                for (int e = 0; e < 4; ++e) { const f32x4 wg = *(const f32x4*)(F.rgw + (size_t)(k + e) * 4);
                    gl[0] += v[j][e] * wg.x; gl[1] += v[j][e] * wg.y; gl[2] += v[j][e] * wg.z; gl[3] += v[j][e] * wg.w; } }
#pragma unroll
            for (int e = 0; e < 4; ++e) gl[e] = wave_sum(gl[e]) + F.rgb[e];
            int g = 0; float gm = gl[0];
#pragma unroll
            for (int e = 1; e < 4; ++e) if (gl[e] > gm) { gm = gl[e]; g = e; }
            const float pg = 1.f / (__expf(gl[0] - gm) + __expf(gl[1] - gm) + __expf(gl[2] - gm) + __expf(gl[3] - gm));
            float el[4] = {0.f, 0.f, 0.f, 0.f};
            const float* we = F.rew + (size_t)g * D * 4;
#pragma unroll
            for (int j = 0; j < 4; ++j) { const int k = 4 * F.lane + 256 * j;
#pragma unroll
                for (int e = 0; e < 4; ++e) { const f32x4 w = *(const f32x4*)(we + (size_t)(k + e) * 4);
                    el[0] += v[j][e] * w.x; el[1] += v[j][e] * w.y; el[2] += v[j][e] * w.z; el[3] += v[j][e] * w.w; } }
#pragma unroll
            for (int e = 0; e < 4; ++e) el[e] = wave_sum(el[e]) + F.reb[g * 4 + e];
            int i1 = 0; float v1 = el[0];
#pragma unroll
            for (int e = 1; e < 4; ++e) if (el[e] > v1) { v1 = el[e]; i1 = e; }
            int i2 = -1; float v2 = -3.0e38f;
#pragma unroll
            for (int e = 0; e < 4; ++e) if (e != i1 && el[e] > v2) { v2 = el[e]; i2 = e; }
            const float p2 = 1.f / (1.f + __expf(v1 - v2)), p1 = 1.f - p2;
            const int lo = i1 < i2 ? i1 : i2, hi = i1 < i2 ? i2 : i1;
            const float glo = pg * (i1 < i2 ? p1 : p2), ghi = pg * (i1 < i2 ? p2 : p1);
            const int pidx = lo == 0 ? hi - 1 : (lo == 1 ? 1 + hi : 5);
            if (F.lane == 0) { s_cls[tl] = g * 6 + pidx; s_glo[tl] = glo; s_ghi[tl] = ghi; }
        }
        LDS_WAIT(); __syncthreads();
        if (F.tid < NCLS) { int n = 0;
            for (int i = 0; i < 64; ++i) n += (s_cls[i] == F.tid) ? 1 : 0;
            int base = 0; if (n > 0) base = (int)__hip_atomic_fetch_add((unsigned*)(F.ctl + CW_CLS + 64 * F.tid), (unsigned)n, RLX_AGENT);
            s_base[F.tid] = base; }
        LDS_WAIT(); __syncthreads();
        if (F.tid < 64) { const int c = s_cls[F.tid]; int rank = 0;
            for (int i = 0; i < F.tid; ++i) rank += (s_cls[i] == c) ? 1 : 0;
            ListEnt e; e.tok = blk * 64 + F.tid; e.glo = s_glo[F.tid]; e.ghi = s_ghi[F.tid]; e.pad = 0;
            F.LIST[(size_t)c * LCAP + s_base[c] + rank] = e; }
        LDS_WAIT(); __syncthreads();
    }
}
__device__ __forceinline__ void cls_experts(int cls, int& elo, int& ehi) { const int g = cls / 6, p = cls % 6; const int lo = p < 3 ? 0 : (p < 5 ? 1 : 2), hi = p < 3 ? p + 1 : (p < 5 ? p - 1 : 3); elo = 4 * g + lo; ehi = 4 * g + hi; }
__device__ __forceinline__ void moe_tab_build(Frame& F) {
    LAS int* tab = (LAS int*)(F.lds + MOETAB_OFF);
    if (F.tid == 0) { int t = 0;
        for (int c = 0; c < NCLS; ++c) { const int n = (int)__hip_atomic_load((unsigned*)(F.ctl + CW_CLS + 64 * c), RLX_AGENT); tab[c] = n; tab[32 + c] = t; t += (n + 255) >> 8; }
        tab[32 + NCLS] = t; }
    LDS_WAIT(); __syncthreads();
}
struct MoeOrderBase {
    const LAS int* tab; int G, c, ncol, nunits;
    __device__ __forceinline__ bool decode(int i, pg8::Unit& u) const {
        const long L = (long)i * G + c; if (L >= nunits) return false;
        const int wgid = pg8::xcd_remap((int)L, nunits);
        const int rt = wgid / ncol; u.pm = rt; u.pn = wgid % ncol;
        int cls = 0;
        for (int k = 1; k < NCLS; ++k) if (rt >= tab[32 + k]) cls = k;
        u.x0 = cls; u.x1 = tab[cls] - (rt - tab[32 + cls]) * 256;
        return true;
    }
};
struct UpOrder : MoeOrderBase {
    static constexpr bool GATHER = true;
    const bf16* HN; const bf16* W1T; const bf16* W3T; const ListEnt* list;
    __device__ __forceinline__ bool next(int i, pg8::Unit& u) const { return decode(i, u); }
    __device__ __forceinline__ const char* a_base(const pg8::Unit&) const { return (const char*)HN; }
    __device__ __forceinline__ void a_voff(const pg8::Unit& u, const int (&R)[2], const int (&C)[2], unsigned (&v)[2][2]) const {
        const int slot0 = (u.pm - tab[32 + u.x0]) * 256;
#pragma unroll
        for (int h = 0; h < 2; ++h)
#pragma unroll
            for (int i = 0; i < 2; ++i) { const int r = h * 128 + R[i]; int tok = 0; if (r < u.x1) tok = list[(size_t)u.x0 * LCAP + slot0 + r].tok;
                v[h][i] = (unsigned)(tok * D + C[i]) * 2u; }
    }
    __device__ __forceinline__ const char* b_base(const pg8::Unit& u, int half, int kt) const {
        int elo, ehi; cls_experts(u.x0, elo, ehi); const int e = u.pn < 4 ? elo : ehi;
        const bf16* W = half ? W3T : W1T;
        return (const char*)W + ((size_t)(e * FF + (u.pn & 3) * 128) * D + (size_t)kt * 64) * 2;
    }
};
struct DownOrder : MoeOrderBase {
    static constexpr bool GATHER = false;
    const bf16* HID; const bf16* W2T;
    __device__ __forceinline__ bool next(int i, pg8::Unit& u) const { return decode(i, u); }
    __device__ __forceinline__ const char* a_base(const pg8::Unit& u) const { return (const char*)HID + (size_t)u.pm * 256 * D * 2; }
    __device__ __forceinline__ void a_voff(const pg8::Unit&, const int (&R)[2], const int (&C)[2], unsigned (&v)[2][2]) const {
#pragma unroll
        for (int h = 0; h < 2; ++h)
#pragma unroll
            for (int i = 0; i < 2; ++i) v[h][i] = (unsigned)((h * 128 + R[i]) * D + C[i]) * 2u;
    }
    __device__ __forceinline__ const char* b_base(const pg8::Unit& u, int half, int kt) const {
        int elo, ehi; cls_experts(u.x0, elo, ehi); const int e = kt < 8 ? elo : ehi;
        return (const char*)W2T + ((size_t)(e * D + u.pn * 256 + half * 128) * FF + (size_t)(kt & 7) * 64) * 2;
    }
};
struct EpiUp {
    static constexpr bool PERM = true;
    bf16* HID; const ListEnt* list; const LAS int* tab;
    __device__ __forceinline__ void operator()(const f32x4 (&acc)[2][2][4][2], const pg8::Unit& u, int wr, int wc, int fr, int fq) const {
        const int slot0 = (u.pm - tab[32 + u.x0]) * 256; const bool usehi = u.pn >= 4;
#pragma unroll
        for (int ai = 0; ai < 2; ++ai)
#pragma unroll
            for (int m = 0; m < 4; ++m) { const int r = ai * 128 + wr * 64 + m * 16 + fr;
                float gate = 0.f; if (r < u.x1) { const ListEnt* e = list + (size_t)u.x0 * LCAP + slot0 + r; gate = usehi ? e->ghi : e->glo; }
                const f32x4 a0 = acc[ai][0][m][0], a1 = acc[ai][0][m][1], b0 = acc[ai][1][m][0], b1 = acc[ai][1][m][1];
                float o[8];
#pragma unroll
                for (int j = 0; j < 4; ++j) { o[j] = a0[j] / (1.f + __expf(-a0[j])) * b0[j] * gate; o[4 + j] = a1[j] / (1.f + __expf(-a1[j])) * b1[j] * gate; }
                pg8::u32x4 w; w.x = pg8::cvt_pk_bf16(o[0], o[1]); w.y = pg8::cvt_pk_bf16(o[2], o[3]); w.z = pg8::cvt_pk_bf16(o[4], o[5]); w.w = pg8::cvt_pk_bf16(o[6], o[7]);
                *(pg8::u32x4*)(HID + (size_t)(u.pm * 256 + r) * D + u.pn * 128 + wc * 32 + 8 * fq) = w; }
    }
};
struct EpiDown {
    static constexpr bool PERM = false;
    float* out; const ListEnt* list; const LAS int* tab;
    __device__ __forceinline__ void operator()(const f32x4 (&acc)[2][2][4][2], const pg8::Unit& u, int wr, int wc, int fr, int fq) const {
        const int slot0 = (u.pm - tab[32 + u.x0]) * 256; const int col0 = u.pn * 256 + wc * 32 + 4 * fq;
#pragma unroll
        for (int ai = 0; ai < 2; ++ai)
#pragma unroll
            for (int m = 0; m < 4; ++m) { const int r = ai * 128 + wr * 64 + m * 16 + fr;
                if (r < u.x1) { const int tok = list[(size_t)u.x0 * LCAP + slot0 + r].tok; float* rowp = out + (size_t)tok * D + col0;
#pragma unroll
                    for (int bj = 0; bj < 2; ++bj)
#pragma unroll
                        for (int n = 0; n < 2; ++n) { const f32x4 h = *(const f32x4*)(rowp + bj * 128 + n * 16); *(f32x4*)(rowp + bj * 128 + n * 16) = h + acc[ai][bj][m][n]; } }
                asm volatile("" ::: "memory"); }
    }
};
__device__ __forceinline__ void final_norm(Frame& F) {
    const int gw = F.vcu * NWAVES + F.wave, NGW = F.G * NWAVES;
    for (int m = gw; m < M; m += NGW) {
        GAS f32x4* xr = (GAS f32x4*)(F.out + (size_t)m * D) + F.lane;
        f32x4 v[4]; float s = 0.f;
#pragma unroll
        for (int j = 0; j < 4; ++j) { v[j] = xr[64 * j]; s += (v[j].x * v[j].x + v[j].y * v[j].y) + (v[j].z * v[j].z + v[j].w * v[j].w); }
        const float rstd = 1.f / sqrtf(wave_sum(s) * (1.f / D) + EPS);
#pragma unroll
        for (int j = 0; j < 4; ++j) { const f32x4 g = *(const f32x4*)(F.g_fin + 4 * F.lane + 256 * j); xr[64 * j] = v[j] * rstd * g; }
    }
}

constexpr int NPHASE = 9;
struct Args { const float* in[17]; float* out; unsigned char* ws; int ph_lo, ph_hi; };
__global__ void __launch_bounds__(NWAVES * 64, 2) hybrid_fwd(Args args) {
    extern __shared__ __attribute__((aligned(16))) unsigned char lds[];
    Frame F;
    F.lds = (LAS unsigned char*)lds;
    F.MISC = (volatile LAS unsigned*)(F.lds + MISC_OFF);
    F.tid = threadIdx.x; F.lane = F.tid & 63; F.wave = __builtin_amdgcn_readfirstlane(F.tid >> 6);
    F.G = gridDim.x; { const int bx = blockIdx.x; F.vcu = (F.G % 8 == 0) ? (bx % 8) * (F.G / 8) + bx / 8 : bx; }
    unsigned char* ws = args.ws; F.ws = ws; F.out = args.out;
    F.ctl = (gu32*)(ws + WS_CTL);
    F.x = args.in[0]; F.w_in = args.in[1]; F.w_out = args.in[2]; F.g_mix = args.in[3]; F.g_ffn = args.in[4]; F.g_fin = args.in[5]; F.g_att = args.in[6]; F.rel_bias = args.in[7];
    F.dec_f = args.in[8]; F.dec_b = args.in[9]; F.rgw = args.in[10]; F.rgb = args.in[11]; F.rew = args.in[12]; F.reb = args.in[13]; F.w1 = args.in[14]; F.w3 = args.in[15]; F.w2 = args.in[16];
    F.WinT = (bf16*)(ws + WS_WIN); F.WoutT = (bf16*)(ws + WS_WOUT); F.W1T = (bf16*)(ws + WS_W1); F.W3T = (bf16*)(ws + WS_W3); F.W2T = (bf16*)(ws + WS_W2);
    F.XN = (bf16*)(ws + WS_XN); F.PROJ = (bf16*)(ws + WS_PROJ); F.MIX = (bf16*)(ws + WS_MIX); F.HID = (bf16*)(ws + WS_PROJ);
    F.COS = (float*)(ws + WS_COS); F.SIN = (float*)(ws + WS_SIN); F.BIAS = (float*)(ws + WS_BIAS); F.KV = (float*)(ws + WS_XN);
    F.ATTO = (bf16*)((unsigned char*)args.out + DO_ATTO); F.ATTL = (float*)((unsigned char*)args.out + DO_ATTL);
    F.LIST = (ListEnt*)(ws + WS_LIST);
    for (int u = F.tid; u < (LDS_BYTES - LDSCTL_OFF) / 4; u += NWAVES * 64) ((LAS unsigned*)(F.lds + LDSCTL_OFF))[u] = 0u;
    __syncthreads();
#if MK_PER_PHASE
#define GRID_BAR() do { } while (0)
#else
    XcdBarrier bar = xcd_barrier_post((unsigned*)(F.ctl + CW_BAR), F.MISC + 8);
#define GRID_BAR() xcd_barrier(bar)
#endif
    const int lo = args.ph_lo, hi = args.ph_hi;
#ifndef PHASE_MASK
#define PHASE_MASK 0x1ff
#endif
#define IN(k) (((PHASE_MASK >> (k)) & 1) && lo <= (k) && (k) < hi)
#define BOTH(k) (IN(k) && IN((k) + 1))

    if (IN(0)) { p0_prologue(F); if (BOTH(0)) GRID_BAR(); }
    if (IN(1)) {
        pg8::DenseOrder S; S.init(F.XN, F.WinT, M, PW, D, D, F.G, (int)blockIdx.x);
        pg8::EpiBf16 E{F.PROJ, PW};
        pg8::gemm_phase<pg8::EpiBf16, pg8::DenseOrder, true, true>(F.lds + RING_OFF, S, E, D, D);
        if (BOTH(1)) GRID_BAR();
    }
    if (IN(2)) { mx::attn_phase(F); mx::ret_kv_phase(F); if (BOTH(2)) GRID_BAR(); }
    if (IN(3)) { mx::ret_out_phase(F); attn_combine(F); if (BOTH(3)) GRID_BAR(); }
    if (IN(4)) {
        pg8::DenseOrder S; S.init(F.MIX, F.WoutT, M, D, D, D, F.G, (int)blockIdx.x);
        pg8::EpiResF32 E{F.x, F.out, D};
        pg8::gemm_phase<pg8::EpiResF32, pg8::DenseOrder, true, true>(F.lds + RING_OFF, S, E, D, D);
        if (BOTH(4)) GRID_BAR();
    }
    if (IN(5)) { router(F); if (BOTH(5)) GRID_BAR(); }
    if (IN(6)) {
        moe_tab_build(F);
        const LAS int* tab = (const LAS int*)(F.lds + MOETAB_OFF);
        UpOrder S; S.tab = tab; S.G = F.G; S.c = (int)blockIdx.x; S.ncol = 8; S.nunits = tab[32 + NCLS] * 8; S.HN = F.XN; S.W1T = F.W1T; S.W3T = F.W3T; S.list = F.LIST;
        EpiUp E{F.HID, F.LIST, tab};
        pg8::gemm_phase<EpiUp, UpOrder, true, true>(F.lds + RING_OFF, S, E, D, D);
        if (BOTH(6)) GRID_BAR();
    }
    if (IN(7)) {
        moe_tab_build(F);
        const LAS int* tab = (const LAS int*)(F.lds + MOETAB_OFF);
        DownOrder S; S.tab = tab; S.G = F.G; S.c = (int)blockIdx.x; S.ncol = 4; S.nunits = tab[32 + NCLS] * 4; S.HID = F.HID; S.W2T = F.W2T;
        EpiDown E{F.out, F.LIST, tab};
        pg8::gemm_phase<EpiDown, DownOrder, true, true>(F.lds + RING_OFF, S, E, FF, D);
        if (BOTH(7)) GRID_BAR();
    }
    if (IN(8)) { final_norm(F); }
#undef IN
#undef BOTH
}

extern "C" void kernel_launch(void* const* d_in, const int* in_sizes, int n_in, void* d_out, int out_size, void* d_ws, size_t ws_size, hipStream_t stream) {
    static int grid = 0;
    if (grid == 0) {
        if (n_in != 17 || in_sizes[0] != M * D || out_size != M * D || ws_size < WS_END) { fprintf(stderr, "kernel_launch: unexpected shapes (n_in %d, in0 %d, out %d, ws %zu)\n", n_in, n_in > 0 ? in_sizes[0] : -1, out_size, ws_size); grid = -1; return; }
        int dev = 0, cus = 0, per_cu = 0;
        if (hipGetDevice(&dev) != hipSuccess || hipDeviceGetAttribute(&cus, hipDeviceAttributeMultiprocessorCount, dev) != hipSuccess) { grid = -1; return; }
        if (hipFuncSetAttribute((const void*)hybrid_fwd, hipFuncAttributeMaxDynamicSharedMemorySize, LDS_BYTES) != hipSuccess) { fprintf(stderr, "kernel_launch: hipFuncSetAttribute failed\n"); grid = -1; return; }
        if (hipOccupancyMaxActiveBlocksPerMultiprocessor(&per_cu, (const void*)hybrid_fwd, NWAVES * 64, LDS_BYTES) != hipSuccess || per_cu < 1)
            fprintf(stderr, "kernel_launch: note: occupancy query reports %d workgroups per CU\n", per_cu);
        (void)hipGetLastError();
        grid = cus;
    }
    if (grid < 0) return;
    if (hipMemsetAsync((char*)d_ws + WS_CTL, 0, CTL_ZERO_BYTES, stream) != hipSuccess) return;
    Args a{};
    for (int i = 0; i < 17; ++i) a.in[i] = (const float*)d_in[i];
    a.out = (float*)d_out; a.ws = (unsigned char*)d_ws;
#if MK_PER_PHASE
    for (int p = 0; p < NPHASE; ++p) { a.ph_lo = p; a.ph_hi = p + 1; hipLaunchKernelGGL(hybrid_fwd, dim3(grid), dim3(NWAVES * 64), LDS_BYTES, stream, a); }
#else
    a.ph_lo = 0; a.ph_hi = NPHASE; hipLaunchKernelGGL(hybrid_fwd, dim3(grid), dim3(NWAVES * 64), LDS_BYTES, stream, a);
#endif
}
```

```cpp
#include <hip/hip_runtime.h>
#include <cstdio>
#include <cstdint>

#ifndef MK_PER_PHASE
#define MK_PER_PHASE 0
#endif

#define GAS __attribute__((address_space(1)))
#define LAS __attribute__((address_space(3)))
typedef unsigned short bf16;
typedef unsigned v4u __attribute__((ext_vector_type(4)));
typedef unsigned v2u __attribute__((ext_vector_type(2)));
typedef float f32x4 __attribute__((ext_vector_type(4)));
typedef float f32x2 __attribute__((ext_vector_type(2)));
typedef short bf16x8 __attribute__((ext_vector_type(8)));
typedef GAS unsigned gu32;
#define RLX_AGENT __ATOMIC_RELAXED, __HIP_MEMORY_SCOPE_AGENT
#define LDS_WAIT() asm volatile("s_waitcnt lgkmcnt(0)" ::: "memory")
#define VM_WAIT() asm volatile("s_waitcnt vmcnt(0)" ::: "memory")

constexpr int NB = 8, SEQ = 2048, D = 1024, M = NB * SEQ, PW = 3584, NH = 8, HD = 64;
constexpr int C_AQ = 0, C_AK = 512, C_AV = 1024, C_RQ = 1536, C_RK = 2048, C_RV = 2560, C_RG = 3072;
constexpr int NE = 16, FF = 512, NCLS = 24, LCAP = 16384;
constexpr float EPS = 1e-6f;
constexpr int RC = 128, NCH = SEQ / RC;

constexpr size_t MiB = 1u << 20;
constexpr size_t WS_CTL = 0, CTL_ZERO_BYTES = 1 * MiB;
constexpr size_t WS_COS = 1 * MiB, WS_SIN = WS_COS + 256 * 1024, WS_BIAS = WS_SIN + 256 * 1024;
constexpr size_t WS_WIN = 4 * MiB, WS_WOUT = 11 * MiB, WS_W1 = 13 * MiB, WS_W3 = 29 * MiB, WS_W2 = 45 * MiB;
constexpr size_t WS_XN = 61 * MiB;
constexpr size_t WS_PROJ = 93 * MiB;
constexpr size_t WS_MIX = 205 * MiB;
constexpr size_t WS_LIST = 237 * MiB;
constexpr size_t WS_END = 243 * MiB;
constexpr size_t DO_ATTO = 0, DO_ATTL = 48 * MiB;
constexpr int CW_TMO = 0, CW_CODE = 1, CW_BAR = 4096, CW_CLS = 16384;

constexpr int RING_OFF = 0, RING_BYTES = 131072;
constexpr int LDSCTL_OFF = RING_BYTES, MISC_OFF = LDSCTL_OFF + 320;
constexpr int MOETAB_OFF = LDSCTL_OFF + 1024;
constexpr int RT_OFF = LDSCTL_OFF + 2048;
constexpr int LDS_BYTES = 147456;
constexpr int NWAVES = 8;

struct ListEnt { int tok; float glo, ghi; int pad; };

__device__ __forceinline__ unsigned f2bf(float f) { unsigned u = __builtin_bit_cast(unsigned, f); return (u + 0x7fffu + ((u >> 16) & 1u)) >> 16; }
__device__ __forceinline__ unsigned pk2(float lo, float hi) { return f2bf(lo) | (f2bf(hi) << 16); }
__device__ __forceinline__ float bf_lo(unsigned w) { return __builtin_bit_cast(float, w << 16); }
__device__ __forceinline__ float bf_hi(unsigned w) { return __builtin_bit_cast(float, w & 0xffff0000u); }
__device__ __forceinline__ float wave_sum(float v) {
#pragma unroll
    for (int o = 1; o < 64; o <<= 1) v += __shfl_xor(v, o);
    return v;
}

namespace pg8 {
#define PG8_LAS __attribute__((address_space(3)))
typedef unsigned short bf16_t;
typedef unsigned u32x4 __attribute__((ext_vector_type(4)));
constexpr int BM = 256, BK = 64, HALF = 128, HTB = HALF * BK * 2, STAGE_BYTES = 8 * HTB, NXCD = 8, WGM = 8;

__host__ __device__ __forceinline__ int lds_byte(int r, int c) { const int st = (r >> 4) * 2 + (c >> 5), rr = r & 15, cc = c & 31, ob = rr * 64 + cc * 2; return st * 1024 + (ob ^ (((ob >> 9) & 1) << 5)); }
__host__ __device__ __forceinline__ void stage_rc(int b, int& R, int& C) { const int st = b / 1024, sb = b % 1024, swz = sb ^ (((sb >> 9) & 1) << 5); R = (st >> 1) * 16 + swz / 64; C = (st & 1) * 32 + (swz % 64) / 2; }
__host__ __device__ __forceinline__ int perm32(int rho) { const int n = rho >> 4, i = rho & 15; return 8 * (i >> 2) + 4 * n + (i & 3); }

struct Unit { int pm, pn, x0, x1; };

__device__ __forceinline__ int xcd_remap(int L, int nwg) { const int q = nwg / NXCD, r = nwg % NXCD, xcd = L % NXCD, off = L / NXCD; return (xcd < r ? xcd * (q + 1) : r * (q + 1) + (xcd - r) * q) + off; }

struct DenseOrder {
    static constexpr bool GATHER = false;
    const bf16_t* A; const bf16_t* Bt; int ldA, ldB; int nM, nN, nwg, G, c;
    __device__ void init(const bf16_t* A_, const bf16_t* Bt_, int M_, int N_, int ldA_, int ldB_, int G_, int c_) { A = A_; Bt = Bt_; ldA = ldA_; ldB = ldB_; nM = M_ / BM; nN = N_ / BM; nwg = nM * nN; G = G_; c = c_; }
    __device__ __forceinline__ bool next(int i, Unit& u) const {
        const long L = (long)i * G + c; if (L >= nwg) return false;
        const int wgid = xcd_remap((int)L, nwg);
        const int nig = WGM * nN, gid = wgid / nig, fm = gid * WGM, gsz = (nM - fm) < WGM ? (nM - fm) : WGM;
        u.pm = fm + ((wgid % nig) % gsz); u.pn = (wgid % nig) / gsz; u.x0 = 0; u.x1 = 0; return true;
    }
    __device__ __forceinline__ const char* a_base(const Unit& u) const { return (const char*)A + (size_t)u.pm * BM * ldA * 2; }
    __device__ __forceinline__ void a_voff(const Unit&, const int (&R)[2], const int (&C)[2], unsigned (&v)[2][2]) const {
#pragma unroll
        for (int h = 0; h < 2; ++h)
#pragma unroll
            for (int i = 0; i < 2; ++i) v[h][i] = (unsigned)((h * HALF + R[i]) * ldA + C[i]) * 2u;
    }
    __device__ __forceinline__ const char* b_base(const Unit& u, int half, int kt) const { return (const char*)Bt + ((size_t)(u.pn * BM + half * HALF) * ldB + (size_t)kt * BK) * 2; }
};

__device__ __forceinline__ unsigned cvt_pk_bf16(float lo, float hi) { unsigned r; asm volatile("v_cvt_pk_bf16_f32 %0, %1, %2" : "=v"(r) : "v"(lo), "v"(hi)); return r; }

struct EpiBf16 {
    static constexpr bool PERM = true;
    bf16_t* O; int ldc;
    __device__ __forceinline__ void operator()(const f32x4 (&acc)[2][2][4][2], const Unit& u, int wr, int wc, int fr, int fq) const {
        const int row0 = u.pm * BM + wr * 64 + fr; const int col0 = u.pn * BM + wc * 32 + 8 * fq;
#pragma unroll
        for (int ai = 0; ai < 2; ++ai)
#pragma unroll
            for (int m = 0; m < 4; ++m) { bf16_t* rowp = O + (size_t)(row0 + ai * HALF + m * 16) * ldc + col0;
#pragma unroll
                for (int bj = 0; bj < 2; ++bj) { const f32x4 v0 = acc[ai][bj][m][0], v1 = acc[ai][bj][m][1];
                    u32x4 w; w.x = cvt_pk_bf16(v0[0], v0[1]); w.y = cvt_pk_bf16(v0[2], v0[3]); w.z = cvt_pk_bf16(v1[0], v1[1]); w.w = cvt_pk_bf16(v1[2], v1[3]);
                    *(u32x4*)(rowp + bj * HALF) = w; } }
    }
};
struct EpiResF32 {
    static constexpr bool PERM = false;
    const float* res; float* out; int ldc;
    __device__ __forceinline__ void operator()(const f32x4 (&acc)[2][2][4][2], const Unit& u, int wr, int wc, int fr, int fq) const {
        const int row0 = u.pm * BM + wr * 64 + fr, col0 = u.pn * BM + wc * 32 + 4 * fq;
#pragma unroll
        for (int ai = 0; ai < 2; ++ai)
#pragma unroll
            for (int m = 0; m < 4; ++m) { const size_t off = (size_t)(row0 + ai * HALF + m * 16) * ldc + col0;
#pragma unroll
                for (int bj = 0; bj < 2; ++bj)
#pragma unroll
                    for (int n = 0; n < 2; ++n) { const f32x4 r = *(const f32x4*)(res + off + bj * HALF + n * 16); *(f32x4*)(out + off + bj * HALF + n * 16) = r + acc[ai][bj][m][n]; }
                asm volatile("" ::: "memory"); }
    }
};

template <class Epi, class Sched, bool ALIGN_EPI, bool SP2>
__device__ __forceinline__ void gemm_phase(PG8_LAS unsigned char* lds, const Sched& S, const Epi& E, const int ldB, const int K) {
    const int tid = threadIdx.x, wid = __builtin_amdgcn_readfirstlane(tid >> 6), lane = tid & 63, wr = wid >> 2, wc = wid & 3, fr = lane & 15, fq = lane >> 4;
    const int nt = K / BK;
    int sR[2], sC[2]; unsigned voffB[2];
#pragma unroll
    for (int i = 0; i < 2; ++i) { stage_rc(tid * 16 + i * 8192, sR[i], sC[i]); const int Rb = Epi::PERM ? ((sR[i] & ~31) + perm32(sR[i] & 31)) : sR[i];
        voffB[i] = (unsigned)(Rb * ldB + sC[i]) * 2u; }
    const size_t kstep = (size_t)(BK * 2);
    const unsigned ldsw = (unsigned)wid * 1024u;
    const int aoff = lds_byte(wr * 64 + fr, fq * 8), boff = lds_byte(wc * 32 + fr, fq * 8);
#define PG8_SA(b, h) (((b) * 2 + (h)) * HTB)
#define PG8_SB(b, h) ((4 + (b) * 2 + (h)) * HTB)
#define PG8_STAGE(bufoff, gbase, voff) do { _Pragma("unroll") for (int _i = 0; _i < 2; ++_i) \
        __builtin_amdgcn_global_load_lds((const unsigned*)((const char*)(gbase) + (voff)[_i]), (PG8_LAS unsigned*)(lds + (bufoff) + ldsw + _i * 8192), 16, 0, 0); } while (0)
#define PG8_LDA(dst, b, h) do { _Pragma("unroll") for (int m = 0; m < 4; ++m) _Pragma("unroll") for (int k = 0; k < 2; ++k) dst[m][k] = *(const PG8_LAS bf16x8*)(lds + PG8_SA(b, h) + aoff + m * 2048 + k * 1024); } while (0)
#define PG8_LDB(dst, b, h) do { _Pragma("unroll") for (int n = 0; n < 2; ++n) _Pragma("unroll") for (int k = 0; k < 2; ++k) dst[n][k] = *(const PG8_LAS bf16x8*)(lds + PG8_SB(b, h) + boff + n * 2048 + k * 1024); } while (0)
#define PG8_MMA(ai, bj, At, Bt) do { __builtin_amdgcn_s_setprio(1); _Pragma("unroll") for (int m = 0; m < 4; ++m) _Pragma("unroll") for (int n = 0; n < 2; ++n) _Pragma("unroll") for (int k = 0; k < 2; ++k) \
        acc[ai][bj][m][n] = __builtin_amdgcn_mfma_f32_16x16x32_bf16(Bt[n][k], At[m][k], acc[ai][bj][m][n], 0, 0, 0); __builtin_amdgcn_s_setprio(0); } while (0)
#define PG8_WAIT_V(n) asm volatile("s_waitcnt vmcnt(" #n ")" ::: "memory")
#define PG8_WAIT_L(n) asm volatile("s_waitcnt lgkmcnt(" #n ")" ::: "memory")
#define PG8_BAR __builtin_amdgcn_s_barrier()
#define PG8_SCHED __builtin_amdgcn_sched_barrier(0)
    Unit cur, nxt; int ui = 0;
    if (!S.next(0, cur)) return;
    f32x4 acc[2][2][4][2];
#pragma unroll
    for (int a = 0; a < 2; ++a)
#pragma unroll
        for (int b = 0; b < 2; ++b)
#pragma unroll
            for (int m = 0; m < 4; ++m)
#pragma unroll
                for (int n = 0; n < 2; ++n) acc[a][b][m][n] = (f32x4){0.f, 0.f, 0.f, 0.f};
    bf16x8 At[4][2], B0[2][2], B1[2][2];
    unsigned vA[2][2], vN[2][2];
    S.a_voff(cur, sR, sC, vA);
    const char* cA = S.a_base(cur);
    if constexpr (SP2) {
        PG8_STAGE(PG8_SB(0, 0), S.b_base(cur, 0, 0), voffB); PG8_STAGE(PG8_SB(0, 1), S.b_base(cur, 1, 0), voffB); PG8_STAGE(PG8_SA(0, 0), cA, vA[0]); PG8_STAGE(PG8_SA(0, 1), cA, vA[1]);
        if (wr == 1) PG8_BAR;
        PG8_WAIT_V(2); PG8_BAR;
        PG8_STAGE(PG8_SB(1, 0), S.b_base(cur, 0, 1), voffB); PG8_STAGE(PG8_SA(1, 0), cA + kstep, vA[0]); PG8_STAGE(PG8_SB(1, 1), S.b_base(cur, 1, 1), voffB);
        PG8_WAIT_V(6); PG8_BAR;
    } else {
        PG8_STAGE(PG8_SB(0, 0), S.b_base(cur, 0, 0), voffB); PG8_STAGE(PG8_SA(0, 0), cA, vA[0]); PG8_STAGE(PG8_SB(0, 1), S.b_base(cur, 1, 0), voffB); PG8_STAGE(PG8_SA(0, 1), cA, vA[1]);
        if (wr == 1) PG8_BAR;
        PG8_WAIT_V(4); PG8_BAR;
        PG8_STAGE(PG8_SB(1, 0), S.b_base(cur, 0, 1), voffB); PG8_STAGE(PG8_SA(1, 0), cA + kstep, vA[0]); PG8_STAGE(PG8_SB(1, 1), S.b_base(cur, 1, 1), voffB);
        PG8_WAIT_V(6); PG8_BAR;
    }
    for (;;) {
        const bool has_next = S.next(ui + 1, nxt);
        if (!has_next) nxt = cur;
        const char* nA = S.a_base(nxt);
        if (Sched::GATHER) { S.a_voff(nxt, sR, sC, vN); }
        else {
#pragma unroll
            for (int h = 0; h < 2; ++h)
#pragma unroll
                for (int i = 0; i < 2; ++i) vN[h][i] = vA[h][i]; }
        for (int t = 0; t < nt; t += 2) {
            const bool last = (t == nt - 2);
            const char* a1 = cA + (size_t)(t + 1) * kstep;
            const char* a2 = last ? nA : cA + (size_t)(t + 2) * kstep; const char* a3 = a2 + kstep;
            const Unit& bu = last ? nxt : cur; const int k2 = last ? 0 : t + 2, k3 = k2 + 1;
            const char* b20 = S.b_base(bu, 0, k2); const char* b21 = S.b_base(bu, 1, k2); const char* b30 = S.b_base(bu, 0, k3); const char* b31 = S.b_base(bu, 1, k3);
            unsigned v2[2][2];
#pragma unroll
            for (int h = 0; h < 2; ++h)
#pragma unroll
                for (int i = 0; i < 2; ++i) v2[h][i] = last ? vN[h][i] : vA[h][i];
            if constexpr (SP2) {
            PG8_LDB(B0, 0, 0); PG8_LDB(B1, 0, 1); PG8_SCHED; PG8_LDA(At, 0, 0); PG8_STAGE(PG8_SA(1, 1), a1, vA[1]);
            PG8_WAIT_V(8); PG8_WAIT_L(0); PG8_BAR; PG8_MMA(0, 0, At, B0); PG8_MMA(0, 1, At, B1); PG8_BAR; PG8_SCHED;
            PG8_LDA(At, 0, 1); PG8_STAGE(PG8_SB(0, 0), b20, voffB); PG8_STAGE(PG8_SB(0, 1), b21, voffB); PG8_STAGE(PG8_SA(0, 0), a2, v2[0]);
            PG8_WAIT_V(8); PG8_WAIT_L(0); PG8_BAR; PG8_MMA(1, 0, At, B0); PG8_MMA(1, 1, At, B1); PG8_BAR; PG8_SCHED;
            PG8_LDB(B0, 1, 0); PG8_LDB(B1, 1, 1); PG8_SCHED; PG8_LDA(At, 1, 0); PG8_STAGE(PG8_SA(0, 1), a2, v2[1]);
            PG8_WAIT_V(8); PG8_WAIT_L(0); PG8_BAR; PG8_MMA(0, 0, At, B0); PG8_MMA(0, 1, At, B1); PG8_BAR; PG8_SCHED;
            PG8_LDA(At, 1, 1); PG8_STAGE(PG8_SB(1, 0), b30, voffB); PG8_STAGE(PG8_SB(1, 1), b31, voffB); PG8_STAGE(PG8_SA(1, 0), a3, v2[0]);
            PG8_WAIT_V(8); PG8_WAIT_L(0); PG8_BAR; PG8_MMA(1, 0, At, B0); PG8_MMA(1, 1, At, B1); PG8_BAR; PG8_SCHED;
            } else {
            PG8_LDB(B0, 0, 0); PG8_SCHED; PG8_LDA(At, 0, 0); PG8_STAGE(PG8_SA(1, 1), a1, vA[1]);
            PG8_WAIT_L(8); PG8_BAR; PG8_WAIT_L(0); PG8_MMA(0, 0, At, B0); PG8_BAR; PG8_SCHED;
            PG8_LDB(B1, 0, 1); PG8_STAGE(PG8_SB(0, 0), b20, voffB);
            PG8_BAR; PG8_WAIT_L(0); PG8_MMA(0, 1, At, B1); PG8_BAR;
            PG8_LDA(At, 0, 1); PG8_STAGE(PG8_SA(0, 0), a2, v2[0]);
            PG8_BAR; PG8_WAIT_L(0); PG8_MMA(1, 0, At, B0); PG8_BAR; PG8_SCHED;
            PG8_STAGE(PG8_SB(0, 1), b21, voffB);
            PG8_WAIT_V(6); PG8_BAR; PG8_MMA(1, 1, At, B1); PG8_BAR;
            PG8_LDB(B0, 1, 0); PG8_SCHED; PG8_LDA(At, 1, 0); PG8_STAGE(PG8_SA(0, 1), a2, v2[1]);
            PG8_WAIT_L(8); PG8_BAR; PG8_WAIT_L(0); PG8_MMA(0, 0, At, B0); PG8_BAR; PG8_SCHED;
            PG8_LDB(B1, 1, 1); PG8_STAGE(PG8_SB(1, 0), b30, voffB);
            PG8_BAR; PG8_WAIT_L(0); PG8_MMA(0, 1, At, B1); PG8_BAR;
            PG8_LDA(At, 1, 1); PG8_STAGE(PG8_SA(1, 0), a3, v2[0]);
            PG8_BAR; PG8_WAIT_L(0); PG8_MMA(1, 0, At, B0); PG8_BAR; PG8_SCHED;
            PG8_STAGE(PG8_SB(1, 1), b31, voffB);
            PG8_WAIT_V(6); PG8_BAR; PG8_MMA(1, 1, At, B1); PG8_BAR;
            }
        }
        if constexpr (ALIGN_EPI) { if (wr == 0) PG8_BAR; }
        E(acc, cur, wr, wc, fr, fq);
        if (!has_next) break;
#pragma unroll
        for (int a = 0; a < 2; ++a)
#pragma unroll
            for (int b = 0; b < 2; ++b)
#pragma unroll
                for (int m = 0; m < 4; ++m)
#pragma unroll
                    for (int n = 0; n < 2; ++n) acc[a][b][m][n] = (f32x4){0.f, 0.f, 0.f, 0.f};
        cur = nxt; cA = nA; ++ui;
#pragma unroll
        for (int h = 0; h < 2; ++h)
#pragma unroll
            for (int i = 0; i < 2; ++i) vA[h][i] = vN[h][i];
        if constexpr (ALIGN_EPI) { if (wr == 1) PG8_BAR; }
    }
    PG8_WAIT_V(0);
    if constexpr (!ALIGN_EPI) { if (wr == 0) PG8_BAR; }
    PG8_BAR;
#undef PG8_SA
#undef PG8_SB
#undef PG8_STAGE
#undef PG8_LDA
#undef PG8_LDB
#undef PG8_MMA
#undef PG8_WAIT_V
#undef PG8_WAIT_L
#undef PG8_BAR
#undef PG8_SCHED
}
}

#define XB_TMO      128
#define XB_XCNT(j)  (256  + 64 * (j))
#define XB_XSUB(j)  (1280 + 64 * (j))
#define XB_XGEN(j)  (2304 + 64 * (j))
#define XB_TOP      3328
#define XB_TOPGEN   3392
#define XCD_BAR_WORDS 3456
#define XB_SPIN_CAP (1u << 18)
__device__ __forceinline__ unsigned xb_ld(unsigned* p)              { return __hip_atomic_load(p, __ATOMIC_RELAXED, __HIP_MEMORY_SCOPE_AGENT); }
__device__ __forceinline__ unsigned xb_add(unsigned* p, unsigned v) { return __hip_atomic_fetch_add(p, v, __ATOMIC_RELAXED, __HIP_MEMORY_SCOPE_AGENT); }
__device__ __forceinline__ unsigned xb_xcc_id() { return (unsigned)__builtin_amdgcn_s_getreg((3 << 11) | 20) & 0xFu; }
#define XB_SPIN(cond, bar) do { unsigned _sp = 0; while (cond) { __builtin_amdgcn_s_sleep(1); \
    if ((++_sp & 255u) == 0u) { if (xb_ld(&(bar)[XB_TMO])) break; if (_sp > XB_SPIN_CAP) { atomicAdd(&(bar)[XB_TMO], 1u); break; } } } } while (0)
struct XcdBarrier { unsigned* bar; unsigned x; volatile LAS unsigned* st; };
__device__ __forceinline__ XcdBarrier xcd_barrier_post(unsigned* bar, volatile LAS unsigned* st) {
    XcdBarrier b; b.bar = bar; b.x = xb_xcc_id(); b.st = st;
    if (threadIdx.x == 0) (void)xb_add(&bar[XB_XCNT(b.x)], 1u);
    return b;
}
__device__ __forceinline__ void xcd_barrier_complete(unsigned* bar, unsigned x, unsigned& nloc, unsigned& nx) {
    const unsigned G = gridDim.x * gridDim.y * gridDim.z;
    unsigned sum, cnt, mine, sp = 0u;
    for (;;) {
        sum = 0u; cnt = 0u; mine = 0u;
#pragma unroll
        for (unsigned j = 0; j < 16; ++j) { const unsigned c = xb_ld(&bar[XB_XCNT(j)]); sum += c; cnt += (c > 0u) ? 1u : 0u; mine = (j == x) ? c : mine; }
        if (sum == G) break;
        __builtin_amdgcn_s_sleep(1);
        if ((++sp & 255u) == 0u) { if (xb_ld(&bar[XB_TMO])) break; if (sp > XB_SPIN_CAP) { atomicAdd(&bar[XB_TMO], 1u); break; } }
    }
    nloc = mine > 0u ? mine : 1u; nx = cnt > 0u ? cnt : 1u;
}
__device__ __forceinline__ void xcd_barrier(const XcdBarrier& b) {
    asm volatile("s_waitcnt vmcnt(0)" ::: "memory");
    __syncthreads();
    if (threadIdx.x == 0) {
        unsigned* bar = b.bar;
        __builtin_amdgcn_s_waitcnt(0);
        unsigned nloc = b.st[0], nx = b.st[1];
        if (nloc == 0u) { xcd_barrier_complete(bar, b.x, nloc, nx); b.st[0] = nloc; b.st[1] = nx; }
        const unsigned old = xb_add(&bar[XB_XSUB(b.x)], 1u);
        const unsigned gen = old / nloc;
        if (old + 1u == (gen + 1u) * nloc) {
            __builtin_amdgcn_fence(__ATOMIC_RELEASE, "agent");
            asm volatile("s_waitcnt vmcnt(0)" ::: "memory");
            const unsigned og = xb_add(&bar[XB_TOP], 1u);
            const unsigned tg = og / nx;
            if (og + 1u == (tg + 1u) * nx) xb_add(&bar[XB_TOPGEN], 1u);
            else XB_SPIN(xb_ld(&bar[XB_TOPGEN]) == tg, bar);
            __builtin_amdgcn_fence(__ATOMIC_ACQUIRE, "agent");
            xb_add(&bar[XB_XGEN(b.x)], 1u);
            asm volatile("s_waitcnt vmcnt(0)" ::: "memory");
        } else {
            XB_SPIN(xb_ld(&bar[XB_XGEN(b.x)]) == gen, bar);
            __builtin_amdgcn_fence(__ATOMIC_ACQUIRE, "agent");
            asm volatile("s_waitcnt vmcnt(0)" ::: "memory");
        }
    }
    __syncthreads();
}

constexpr int PTAB_OFF = LDSCTL_OFF + 512;
struct Frame {
    LAS unsigned char* lds;
    volatile LAS unsigned* MISC;
    gu32* ctl;
    int tid, lane, wave, vcu, G;
    unsigned char* ws; float* out;
    __device__ __forceinline__ const float* inp(int k) const { const volatile LAS unsigned* t = (const volatile LAS unsigned*)(lds + PTAB_OFF) + 2 * k;
        const unsigned lo = __builtin_amdgcn_readfirstlane(t[0]), hi = __builtin_amdgcn_readfirstlane(t[1]); return (const float*)(((unsigned long long)hi << 32) | lo); }
#define FIN(name, k) __device__ __forceinline__ const float* name() const { return inp(k); }
    FIN(x, 0) FIN(w_in, 1) FIN(w_out, 2) FIN(g_mix, 3) FIN(g_ffn, 4) FIN(g_fin, 5) FIN(g_att, 6) FIN(rel_bias, 7) FIN(dec_f, 8) FIN(dec_b, 9)
    FIN(rgw, 10) FIN(rgb, 11) FIN(rew, 12) FIN(reb, 13) FIN(w1, 14) FIN(w3, 15) FIN(w2, 16)
#undef FIN
#define FWS(T, name, off) __device__ __forceinline__ T* name() const { return (T*)(ws + (off)); }
    FWS(bf16, WinT, WS_WIN) FWS(bf16, WoutT, WS_WOUT) FWS(bf16, W1T, WS_W1) FWS(bf16, W3T, WS_W3) FWS(bf16, W2T, WS_W2)
    FWS(bf16, XN, WS_XN) FWS(bf16, PROJ, WS_PROJ) FWS(bf16, MIX, WS_MIX) FWS(bf16, HID, WS_PROJ)
    FWS(float, COS, WS_COS) FWS(float, SIN, WS_SIN) FWS(float, BIAS, WS_BIAS) FWS(float, KV, WS_XN) FWS(ListEnt, LIST, WS_LIST)
#undef FWS
    __device__ __forceinline__ bf16* ATTO() const { return (bf16*)((unsigned char*)out + DO_ATTO); }
    __device__ __forceinline__ float* ATTL() const { return (float*)((unsigned char*)out + DO_ATTL); }
};


typedef short s16x4_t __attribute__((ext_vector_type(4)));
typedef short v4i16e_t __attribute__((ext_vector_type(4)));
typedef __bf16 bf16x2e_t __attribute__((ext_vector_type(2)));
__device__ __forceinline__ unsigned cvtpk_e(float lo, float hi) { f32x2 v = {lo, hi}; bf16x2e_t b = __builtin_convertvector(v, bf16x2e_t); return __builtin_bit_cast(unsigned, b); }
__device__ __forceinline__ s16x4_t vtr_e(const LAS unsigned char* p) { return __builtin_bit_cast(s16x4_t, __builtin_amdgcn_ds_read_tr16_b64_v4i16((LAS v4i16e_t*)p)); }
__device__ __forceinline__ int v_off_e(int row, int ch) { return ((row >> 3) * 2 + (ch >> 2)) * 512 + (row & 7) * 64 + (ch & 3) * 16; }
__device__ __forceinline__ void p0_transpose64(const float* W, int K, int N, bf16* WT, LAS unsigned char* img, int item, int lane, const float* ksc, int klim, float csc) {
    const int nblk = N / 64, kb = item / nblk, nb = item % nblk, k0 = 64 * kb, n0 = 64 * nb;
    const int kr = lane >> 4, n4 = (lane & 15) * 4;
    f32x4 v[16];
#pragma unroll
    for (int i = 0; i < 16; ++i) v[i] = *(const GAS f32x4*)(W + (size_t)(k0 + 4 * i + kr) * N + n0 + n4);
#pragma unroll
    for (int i = 0; i < 16; ++i) { const int k = 4 * i + kr; float s = csc; if (ksc && (k0 + k) < klim) s *= ksc[k0 + k];
        v2u w; w.x = cvtpk_e(v[i].x * s, v[i].y * s); w.y = cvtpk_e(v[i].z * s, v[i].w * s);
        *(LAS v2u*)(img + v_off_e(k, n4 >> 3) + (n4 & 7) * 2) = w; }
    LDS_WAIT(); asm volatile("" ::: "memory");
    const int hh = lane >> 5, i16 = lane & 15, q4 = i16 >> 2, p4 = i16 & 3, blk = (lane >> 4) & 1;
#pragma unroll
    for (int s = 0; s < 4; ++s)
#pragma unroll
        for (int mt = 0; mt < 2; ++mt) { const int rlo = 16 * s + 8 * hh + q4, ch = 4 * mt + 2 * blk + (p4 >> 1);
            const s16x4_t lo = vtr_e(img + v_off_e(rlo, ch) + (p4 & 1) * 8), hi = vtr_e(img + v_off_e(rlo + 4, ch) + (p4 & 1) * 8);
            const bf16x8 o = __builtin_shufflevector(lo, hi, 0, 1, 2, 3, 4, 5, 6, 7);
            *(GAS bf16x8*)(WT + (size_t)(n0 + 32 * mt + (lane & 31)) * K + k0 + 16 * s + 8 * hh) = o; }
    LDS_WAIT(); asm volatile("" ::: "memory");
}
__device__ __forceinline__ void p0_transpose_item(const float* W, int K, int N, bf16* WT, int row_off, LAS float* scr, int item, int lane, const float* ksc, int klim, float csc) {
    const int nblk = N / 32, kb = item / nblk, nb = item % nblk, k0 = 64 * kb, n0 = 32 * nb;
#pragma unroll 8
    for (int i = 0; i < 32; ++i) { const int kk = 2 * i + (lane >> 5); const int k = k0 + kk; float s = csc; if (ksc && k < klim) s *= ksc[k];
        scr[kk * 33 + (lane & 31)] = W[(size_t)k * N + n0 + (lane & 31)] * s; }
    LDS_WAIT(); asm volatile("" ::: "memory");
    const int c = lane & 7;
#pragma unroll
    for (int j = 0; j < 4; ++j) { const int n = (lane >> 3) + 8 * j; const LAS float* s = scr + (8 * c) * 33 + n;
        v4u o; o.x = pk2(s[0 * 33], s[1 * 33]); o.y = pk2(s[2 * 33], s[3 * 33]); o.z = pk2(s[4 * 33], s[5 * 33]); o.w = pk2(s[6 * 33], s[7 * 33]);
        *(GAS v4u*)(WT + (size_t)(row_off + n0 + n) * K + k0 + 8 * c) = o; }
    LDS_WAIT(); asm volatile("" ::: "memory");
}
__device__ __forceinline__ int t5_bucket(int rel) {
    const int n = rel < 0 ? -rel : rel; const int off = rel > 0 ? 16 : 0;
    if (n < 8) return off + n;
    int large = 8 + (int)(logf((float)n / 8.0f) / logf(128.0f) * 8.0f);
    if (large > 15) large = 15;
    return off + large;
}
__device__ __forceinline__ void p0_prologue(Frame& F) {
    LAS unsigned char* img = F.lds + RING_OFF + F.wave * 8192;
    const int gw = F.vcu * NWAVES + F.wave, NGW = F.G * NWAVES;
    constexpr int I_IN = (D / 64) * (PW / 64), I_OUT = (D / 64) * (D / 64);
    constexpr int NITEMS = I_IN + I_OUT;
    for (int it = gw; it < NITEMS; it += NGW) {
        int r = it;
        if (r < I_IN) { const int n0 = 64 * (r % (PW / 64)); const float csc = (n0 < C_AK || (n0 >= C_RK && n0 < C_RV)) ? 0.125f : 1.0f;
            p0_transpose64(F.w_in(), D, PW, F.WinT(), img, r, F.lane, F.g_mix(), D, csc); continue; } r -= I_IN;
        p0_transpose64(F.w_out(), D, D, F.WoutT(), img, r, F.lane, F.g_att(), 512, 1.0f);
    }
    const float* x_ = F.x();
    for (int m = gw; m < M; m += NGW) {
        const GAS f32x4* xr = (const GAS f32x4*)(x_ + (size_t)m * D) + F.lane;
        f32x4 v[4]; float s = 0.f;
#pragma unroll
        for (int j = 0; j < 4; ++j) { v[j] = xr[64 * j]; s += (v[j].x * v[j].x + v[j].y * v[j].y) + (v[j].z * v[j].z + v[j].w * v[j].w); }
        const float rstd = 1.f / sqrtf(wave_sum(s) * (1.f / D) + EPS);
        GAS unsigned long long* o8 = (GAS unsigned long long*)(F.XN() + (size_t)m * D) + F.lane;
#pragma unroll
        for (int j = 0; j < 4; ++j) o8[64 * j] = (unsigned long long)pk2(v[j].x * rstd, v[j].y * rstd) | ((unsigned long long)pk2(v[j].z * rstd, v[j].w * rstd) << 32);
    }
    const int gt = F.vcu * 512 + F.tid, NGT = F.G * 512;
    for (int i = gt; i < SEQ * 32; i += NGT) {
        const int pos = i >> 5, fi = i & 31;
        const float inv = powf(10000.0f, -(float)fi / 32.0f);
        const float ang = (float)pos * inv;
        const double a = (double)ang; const double k = rint(a * 0.15915494309189535); const double rr = a - k * 6.283185307179586477;
        F.COS()[i] = (float)cos(rr); F.SIN()[i] = (float)sin(rr);
    }
    const float* rb_ = F.rel_bias();
    for (int i = gt; i < 3 * NH * 132; i += NGT) {
        const int dl = i % 132, h = (i / 132) % NH, br = i / (132 * NH); const int d = br == 0 ? 1 : (br == 1 ? 4 : 16);
        float v = 0.f; if (dl <= 128) v = rb_[t5_bucket((dl - 64) * d) * NH + h];
        F.BIAS()[i] = v;
    }
}

constexpr int CW_WQ = 20480;
__device__ __forceinline__ void expert_convert_queue(Frame& F) {
    constexpr int I_UP = (D / 64) * (FF / 64), I_DN = (FF / 64) * (D / 64), PER_E = 2 * I_UP + I_DN, NITEMS_E = NE * PER_E;
    LAS unsigned char* img = F.lds + RING_OFF + F.wave * 8192;
    volatile LAS int* s_q = (volatile LAS int*)(F.lds + RT_OFF + 1024);
    for (;;) {
        if (F.tid == 0) s_q[0] = (int)__hip_atomic_fetch_add((unsigned*)(F.ctl + CW_WQ), 1u, RLX_AGENT);
        LDS_WAIT(); __syncthreads();
        const int base = s_q[0] * NWAVES;
        __syncthreads();
        if (base >= NITEMS_E) break;
        int r = base + F.wave;
        if (r < NITEMS_E) {
            const int e = r / PER_E; r -= e * PER_E;
            if (r < I_UP) p0_transpose64(F.w1() + (size_t)e * D * FF, D, FF, F.W1T() + (size_t)e * FF * D, img, r, F.lane, F.g_ffn(), D, 1.0f);
            else if (r < 2 * I_UP) p0_transpose64(F.w3() + (size_t)e * D * FF, D, FF, F.W3T() + (size_t)e * FF * D, img, r - I_UP, F.lane, F.g_ffn(), D, 1.0f);
            else p0_transpose64(F.w2() + (size_t)e * FF * D, FF, D, F.W2T() + (size_t)e * D * FF, img, r - 2 * I_UP, F.lane, nullptr, 0, 1.0f);
        }
    }
}
__device__ __forceinline__ void rotary_inplace(Frame& F) {
    const long gt = (long)F.vcu * 512 + F.tid, NGT = (long)F.G * 512;
    const long total = (long)M * 2 * NH * 8;
    for (long u = gt; u < total; u += NGT) {
        const int g4 = (int)(u & 7), h = (int)((u >> 3) & 7), qk = (int)((u >> 6) & 1); const int tok = (int)(u >> 7);
        const int pos = tok & (SEQ - 1);
        bf16* base = F.PROJ() + (size_t)tok * PW + (qk ? C_RK : C_RQ) + h * HD + 4 * g4;
        const v2u a = *(const v2u*)base, b = *(const v2u*)(base + 32);
        const f32x4 c = *(const f32x4*)(F.COS() + pos * 32 + 4 * g4), s = *(const f32x4*)(F.SIN() + pos * 32 + 4 * g4);
        const float t1[4] = {bf_lo(a.x), bf_hi(a.x), bf_lo(a.y), bf_hi(a.y)}, t2[4] = {bf_lo(b.x), bf_hi(b.x), bf_lo(b.y), bf_hi(b.y)};
        float o1[4], o2[4];
#pragma unroll
        for (int j = 0; j < 4; ++j) { o1[j] = t1[j] * c[j] - t2[j] * s[j]; o2[j] = t1[j] * s[j] + t2[j] * c[j]; }
        v2u wa, wb; wa.x = pk2(o1[0], o1[1]); wa.y = pk2(o1[2], o1[3]); wb.x = pk2(o2[0], o2[1]); wb.y = pk2(o2[2], o2[3]);
        *(v2u*)base = wa; *(v2u*)(base + 32) = wb;
    }
}
__device__ __forceinline__ void load_row64(const bf16* p, float (&v)[64]) {
#pragma unroll
    for (int c = 0; c < 8; ++c) { const v4u w = *(const v4u*)(p + 8 * c);
        v[8 * c + 0] = bf_lo(w.x); v[8 * c + 1] = bf_hi(w.x); v[8 * c + 2] = bf_lo(w.y); v[8 * c + 3] = bf_hi(w.y);
        v[8 * c + 4] = bf_lo(w.z); v[8 * c + 5] = bf_hi(w.z); v[8 * c + 6] = bf_lo(w.w); v[8 * c + 7] = bf_hi(w.w); }
}
__device__ __forceinline__ void attn_naive(Frame& F) {
    const long gt = (long)F.vcu * 512 + F.tid, NGT = (long)F.G * 512;
    const long total = 3L * NB * NH * SEQ;
    for (long u = gt; u < total; u += NGT) {
        const int p = (int)(u & (SEQ - 1)), h = (int)((u >> 11) & 7), b = (int)((u >> 14) & 7), br = (int)(u >> 17);
        const int sh = 2 * br, d = 1 << sh, r = p & (d - 1), a = p >> sh, L = SEQ >> sh;
        float q[64]; load_row64(F.PROJ() + (size_t)(b * SEQ + p) * PW + C_AQ + h * HD, q);
        float acc[64];
#pragma unroll
        for (int i = 0; i < 64; ++i) acc[i] = 0.f;
        float mx = -1e30f, l = 0.f;
        const int j0 = a - 64 < 0 ? 0 : a - 64, j1 = a + 64 > L - 1 ? L - 1 : a + 64;
        const float* bias = F.BIAS() + (br * NH + h) * 132 + 64;
        for (int j = j0; j <= j1; ++j) {
            const size_t row = (size_t)(b * SEQ + (j << sh) + r) * PW;
            float kv[64]; load_row64(F.PROJ() + row + C_AK + h * HD, kv);
            float s = 0.f;
#pragma unroll
            for (int i = 0; i < 64; ++i) s += q[i] * kv[i];
            s += bias[j - a];
            const float mn = fmaxf(mx, s), sc = __expf(mx - mn), pp = __expf(s - mn);
            load_row64(F.PROJ() + row + C_AV + h * HD, kv);
            l = l * sc + pp;
#pragma unroll
            for (int i = 0; i < 64; ++i) acc[i] = acc[i] * sc + pp * kv[i];
            mx = mn;
        }
        const float il = 1.f / l;
        bf16* o = F.ATTO() + ((size_t)br * M + (size_t)(b * SEQ + p)) * 512 + h * HD;
#pragma unroll
        for (int c = 0; c < 8; ++c) { v4u w; w.x = pk2(acc[8 * c] * il, acc[8 * c + 1] * il); w.y = pk2(acc[8 * c + 2] * il, acc[8 * c + 3] * il);
            w.z = pk2(acc[8 * c + 4] * il, acc[8 * c + 5] * il); w.w = pk2(acc[8 * c + 6] * il, acc[8 * c + 7] * il); *(v4u*)(o + 8 * c) = w; }
        F.ATTL()[((size_t)br * M + (size_t)(b * SEQ + p)) * NH + h] = mx + __logf(l);
    }
}

namespace mx {
typedef float f32x16 __attribute__((ext_vector_type(16)));
typedef short s16x4 __attribute__((ext_vector_type(4)));
typedef short v4i16_t __attribute__((ext_vector_type(4)));
typedef __bf16 bf16x2_t __attribute__((ext_vector_type(2)));
__device__ __forceinline__ unsigned cvtpk(float lo, float hi) { f32x2 v = {lo, hi}; bf16x2_t b = __builtin_convertvector(v, bf16x2_t); return __builtin_bit_cast(unsigned, b); }
__device__ __forceinline__ s16x4 vtr(const LAS unsigned char* p) { return __builtin_bit_cast(s16x4, __builtin_amdgcn_ds_read_tr16_b64_v4i16((LAS v4i16_t*)p)); }
__device__ __forceinline__ int crow(int r, int hi) { return (r & 3) + 8 * (r >> 2) + 4 * hi; }
__device__ __forceinline__ int k_off(int row, int ch) { return row * 128 + ((ch ^ ((row >> 1) & 7)) << 4); }
__device__ __forceinline__ int v_off(int row, int ch) { return ((row >> 3) * 2 + (ch >> 2)) * 512 + (row & 7) * 64 + (ch & 3) * 16; }
#define MFMA32(a, b, c) __builtin_amdgcn_mfma_f32_32x32x16_bf16((a), (b), (c), 0, 0, 0)
constexpr float LOG2E = 1.4426950408889634f, LN2 = 0.6931471805599453f;

constexpr int AT_K = 0, AT_V = 49152, AT_B = 98304;
constexpr int AT_UNITS = NB * NH * 24;
__device__ __forceinline__ void attn_unit(Frame& F, int u) {
    const int sub = u & 7, br = (u >> 3) % 3, bh = u / 24, b = bh >> 3, h = bh & 7;
    const int sh = 2 * br, L = SEQ >> sh;
    int r0, r1, q0, kbase, nk, nrows;
    if (br < 2) { r0 = (br == 0) ? 0 : (sub >> 1); r1 = r0; q0 = (br == 0) ? sub * 256 : (sub & 1) * 256; kbase = q0 - 64 < 0 ? 0 : q0 - 64; const int kend = q0 + 320 > L ? L : q0 + 320; nk = kend - kbase; nrows = nk; }
    else { r0 = 2 * sub; r1 = r0 + 1; q0 = 0; kbase = 0; nk = 128; nrows = 256; }
    LAS unsigned char* lds = F.lds;
    __syncthreads();
    {
        v4u kr[6], vr[6];
#pragma unroll
        for (int it = 0; it < 6; ++it) { const int c = F.tid + 512 * it, row = c >> 3, ch = c & 7;
            if (row < nrows) { const int seg = (br == 2) ? (row >> 7) : 0, li = row - seg * nk; const int tok = b * SEQ + ((kbase + li) << sh) + (seg ? r1 : r0);
                const bf16* p = F.PROJ() + (size_t)tok * PW + h * HD + ch * 8; kr[it] = *(const v4u*)(p + C_AK); vr[it] = *(const v4u*)(p + C_AV); } }
#pragma unroll
        for (int it = 0; it < 6; ++it) { const int c = F.tid + 512 * it, row = c >> 3, ch = c & 7;
            if (row < nrows) { *(LAS v4u*)(lds + AT_K + k_off(row, ch)) = kr[it]; *(LAS v4u*)(lds + AT_V + v_off(row, ch)) = vr[it]; } }
        if (F.tid < 192) { const int dl = F.tid - 32; float v = 0.f; if (dl >= 0 && dl <= 128) v = F.BIAS()[(br * NH + h) * 132 + dl]; ((LAS float*)(lds + AT_B))[F.tid] = v * LOG2E; }
    }
    const int w = F.wave, lane = F.lane, qc = lane & 31, hh = lane >> 5;
    const int seg = (br == 2) ? (w >> 2) : 0, qs = (br == 2) ? 32 * (w & 3) : q0 + 32 * w;
    const int tq = b * SEQ + ((qs + qc) << sh) + (seg ? r1 : r0);
    bf16x8 qf[4];
    { const bf16* qp = F.PROJ() + (size_t)tq * PW + C_AQ + h * HD + 8 * hh;
#pragma unroll
      for (int s = 0; s < 4; ++s) qf[s] = *(const bf16x8*)(qp + 16 * s); }
    LDS_WAIT(); __syncthreads();
    f32x16 S[5];
    bool valid[5];
    const LAS float* bl = (const LAS float*)(lds + AT_B);
#pragma unroll
    for (int t = 0; t < 5; ++t) {
        const int kp = qs + 32 * (t - 2); valid[t] = (kp >= 0) && (kp < L);
        const int R0 = seg * nk + (kp - kbase);
#pragma unroll
        for (int i = 0; i < 16; ++i) S[t][i] = 0.f;
        if (valid[t]) {
#pragma unroll
            for (int s = 0; s < 4; ++s) { const bf16x8 a = *(const LAS bf16x8*)(lds + AT_K + k_off(R0 + qc, 2 * s + hh)); S[t] = MFMA32(a, qf[s], S[t]); }
#pragma unroll
            for (int i = 0; i < 16; ++i) { const int kr = crow(i, hh); const int rel = 32 * (t - 2) + kr - qc; float v = S[t][i] * LOG2E + bl[rel + 96];
                if (t == 0 && kr < qc) v = -1e30f; if (t == 4 && kr > qc) v = -1e30f; S[t][i] = v; }
        } else {
#pragma unroll
            for (int i = 0; i < 16; ++i) S[t][i] = -1e30f;
        }
    }
    float mx = -1e30f;
#pragma unroll
    for (int t = 0; t < 5; ++t)
#pragma unroll
        for (int i = 0; i < 16; ++i) mx = fmaxf(mx, S[t][i]);
    mx = fmaxf(mx, __shfl_xor(mx, 32));
    float l = 0.f;
#pragma unroll
    for (int t = 0; t < 5; ++t)
#pragma unroll
        for (int i = 0; i < 16; ++i) { const float p = __builtin_amdgcn_exp2f(S[t][i] - mx); S[t][i] = p; l += p; }
    l += __shfl_xor(l, 32);
    f32x16 O[2];
#pragma unroll
    for (int i = 0; i < 16; ++i) { O[0][i] = 0.f; O[1][i] = 0.f; }
    const int i16 = lane & 15, q4 = i16 >> 2, p4 = i16 & 3, blk = (lane >> 4) & 1;
#pragma unroll
    for (int t = 0; t < 5; ++t) {
        if (valid[t]) {
            const int R0 = seg * nk + (qs + 32 * (t - 2) - kbase);
#pragma unroll
            for (int s2 = 0; s2 < 2; ++s2) {
                v4u pw; pw.x = cvtpk(S[t][8 * s2 + 0], S[t][8 * s2 + 1]); pw.y = cvtpk(S[t][8 * s2 + 2], S[t][8 * s2 + 3]); pw.z = cvtpk(S[t][8 * s2 + 4], S[t][8 * s2 + 5]); pw.w = cvtpk(S[t][8 * s2 + 6], S[t][8 * s2 + 7]);
                const bf16x8 pb = __builtin_bit_cast(bf16x8, pw);
                const int rlo = R0 + 16 * s2 + 4 * hh + q4;
#pragma unroll
                for (int dt = 0; dt < 2; ++dt) {
                    const int ch = 4 * dt + 2 * blk + (p4 >> 1);
                    const s16x4 lo = vtr(lds + AT_V + v_off(rlo, ch) + (p4 & 1) * 8), hi = vtr(lds + AT_V + v_off(rlo + 8, ch) + (p4 & 1) * 8);
                    const bf16x8 va = __builtin_shufflevector(lo, hi, 0, 1, 2, 3, 4, 5, 6, 7);
                    O[dt] = MFMA32(va, pb, O[dt]);
                }
            }
        }
    }
    const float il = 1.f / l;
    bf16* op = F.ATTO() + ((size_t)br * M + tq) * 512 + h * HD + 4 * hh;
#pragma unroll
    for (int dt = 0; dt < 2; ++dt)
#pragma unroll
        for (int g = 0; g < 4; ++g) { v2u wv; wv.x = cvtpk(O[dt][4 * g] * il, O[dt][4 * g + 1] * il); wv.y = cvtpk(O[dt][4 * g + 2] * il, O[dt][4 * g + 3] * il); *(v2u*)(op + 32 * dt + 8 * g) = wv; }
    if (hh == 0) F.ATTL()[((size_t)br * M + tq) * NH + h] = (mx + __builtin_amdgcn_logf(l)) * LN2;
}
__device__ __forceinline__ void attn_phase(Frame& F) {
    for (int u = F.vcu; u < AT_UNITS; u += F.G) attn_unit(F, u);
    __syncthreads();
}

__device__ __forceinline__ void load_rot8(const Frame& F, const bf16* p, int pos, int ch, float (&o1)[8], float (&o2)[8]) {
    const v4u a = *(const v4u*)(p + 8 * ch), b = *(const v4u*)(p + 32 + 8 * ch);
    const f32x4 c0 = *(const f32x4*)(F.COS() + pos * 32 + 8 * ch), c1 = *(const f32x4*)(F.COS() + pos * 32 + 8 * ch + 4);
    const f32x4 s0 = *(const f32x4*)(F.SIN() + pos * 32 + 8 * ch), s1 = *(const f32x4*)(F.SIN() + pos * 32 + 8 * ch + 4);
    const float t1[8] = {bf_lo(a.x), bf_hi(a.x), bf_lo(a.y), bf_hi(a.y), bf_lo(a.z), bf_hi(a.z), bf_lo(a.w), bf_hi(a.w)};
    const float t2[8] = {bf_lo(b.x), bf_hi(b.x), bf_lo(b.y), bf_hi(b.y), bf_lo(b.z), bf_hi(b.z), bf_lo(b.w), bf_hi(b.w)};
    const float cs[8] = {c0.x, c0.y, c0.z, c0.w, c1.x, c1.y, c1.z, c1.w}, sn[8] = {s0.x, s0.y, s0.z, s0.w, s1.x, s1.y, s1.z, s1.w};
#pragma unroll
    for (int j = 0; j < 8; ++j) { o1[j] = t1[j] * cs[j] - t2[j] * sn[j]; o2[j] = t1[j] * sn[j] + t2[j] * cs[j]; }
}
__device__ __forceinline__ v4u pack8(const float (&o)[8], float s) { v4u w; w.x = cvtpk(o[0] * s, o[1] * s); w.y = cvtpk(o[2] * s, o[3] * s); w.z = cvtpk(o[4] * s, o[5] * s); w.w = cvtpk(o[6] * s, o[7] * s); return w; }
constexpr int R1_UNITS = NB * NH * NCH;
__device__ __forceinline__ void ret_kv_unit(Frame& F, int u) {
    const int c = u & (NCH - 1), bh = u >> 4, b = bh >> 3, h = bh & 7;
    const float lgf = -__expf(F.dec_f()[h]) * LOG2E, lgb = -__expf(F.dec_b()[h]) * LOG2E;
    LAS unsigned char* lds = F.lds;
    __syncthreads();
    { const int row = F.tid >> 2, ch = F.tid & 3; const int pos = c * RC + row, tok = b * SEQ + pos;
      const bf16* p = F.PROJ() + (size_t)tok * PW + h * HD;
      float o1[8], o2[8]; load_rot8(F, p + C_RK, pos, ch, o1, o2);
      const v4u va = *(const v4u*)(p + C_RV + 8 * ch), vb = *(const v4u*)(p + C_RV + 32 + 8 * ch);
      const float df = __builtin_amdgcn_exp2f(lgf * (float)(RC - 1 - row)), db = __builtin_amdgcn_exp2f(lgb * (float)row);
      *(LAS v4u*)(lds + 0 + v_off(row, ch)) = pack8(o1, df); *(LAS v4u*)(lds + 0 + v_off(row, ch + 4)) = pack8(o2, df);
      *(LAS v4u*)(lds + 16384 + v_off(row, ch)) = pack8(o1, db); *(LAS v4u*)(lds + 16384 + v_off(row, ch + 4)) = pack8(o2, db);
      *(LAS v4u*)(lds + 32768 + v_off(row, ch)) = va; *(LAS v4u*)(lds + 32768 + v_off(row, ch + 4)) = vb; }
    LDS_WAIT(); __syncthreads();
    const int w = F.wave, lane = F.lane, hh = lane >> 5, dir = w >> 2, mt = (w >> 1) & 1, nt = w & 1;
    const int i16 = lane & 15, q4 = i16 >> 2, p4 = i16 & 3, blk = (lane >> 4) & 1;
    f32x16 acc;
#pragma unroll
    for (int i = 0; i < 16; ++i) acc[i] = 0.f;
    const LAS unsigned char* kim = lds + dir * 16384; const LAS unsigned char* vim = lds + 32768;
#pragma unroll
    for (int s = 0; s < 8; ++s) {
        const int rlo = 16 * s + 8 * hh + q4;
        const int cha = 4 * mt + 2 * blk + (p4 >> 1), chb = 4 * nt + 2 * blk + (p4 >> 1);
        const s16x4 alo = vtr(kim + v_off(rlo, cha) + (p4 & 1) * 8), ahi = vtr(kim + v_off(rlo + 4, cha) + (p4 & 1) * 8);
        const s16x4 blo = vtr(vim + v_off(rlo, chb) + (p4 & 1) * 8), bhi = vtr(vim + v_off(rlo + 4, chb) + (p4 & 1) * 8);
        acc = MFMA32(__builtin_shufflevector(alo, ahi, 0, 1, 2, 3, 4, 5, 6, 7), __builtin_shufflevector(blo, bhi, 0, 1, 2, 3, 4, 5, 6, 7), acc);
    }
    float* o = F.KV() + ((size_t)(u * 2 + dir)) * 4096 + (32 * mt) * 64 + 32 * nt + (lane & 31);
#pragma unroll
    for (int i = 0; i < 16; ++i) o[crow(i, hh) * 64] = acc[i];
}
constexpr int R2_UNITS = NB * NH * (NCH / 2);
constexpr int R2_CH = 49152, R2_K = 0, R2_V = 16384, R2_SF = 32768, R2_SB = 40960;
__device__ __forceinline__ void ret_out_unit(Frame& F, int u) {
    const int cp = u & 7, bh = u >> 3, b = bh >> 3, h = bh & 7, c0 = 2 * cp, c1 = c0 + 1;
    const float lgf = -__expf(F.dec_f()[h]) * LOG2E, lgb = -__expf(F.dec_b()[h]) * LOG2E;
    LAS unsigned char* lds = F.lds;
    __syncthreads();
#pragma unroll
    for (int j = 0; j < 2; ++j) { const int row = F.tid >> 2, ch = F.tid & 3; const int pos = (c0 + j) * RC + row, tok = b * SEQ + pos;
        const bf16* p = F.PROJ() + (size_t)tok * PW + h * HD;
        float o1[8], o2[8]; load_rot8(F, p + C_RK, pos, ch, o1, o2);
        const v4u va = *(const v4u*)(p + C_RV + 8 * ch), vb = *(const v4u*)(p + C_RV + 32 + 8 * ch);
        LAS unsigned char* cb = lds + j * R2_CH;
        *(LAS v4u*)(cb + R2_K + k_off(row, ch)) = pack8(o1, 1.f); *(LAS v4u*)(cb + R2_K + k_off(row, ch + 4)) = pack8(o2, 1.f);
        *(LAS v4u*)(cb + R2_V + v_off(row, ch)) = va; *(LAS v4u*)(cb + R2_V + v_off(row, ch + 4)) = vb; }
    { const int dk = F.tid >> 3, dv8 = (F.tid & 7) * 8;
      const float* kvb = F.KV() + (size_t)(bh * NCH) * 2 * 4096 + dk * 64 + dv8;
      float sf[8], sb[8];
#pragma unroll
      for (int e = 0; e < 8; ++e) { sf[e] = 0.f; sb[e] = 0.f; }
      for (int cc = 0; cc < c0; ++cc) { const float wgt = __builtin_amdgcn_exp2f(lgf * (float)(RC * (c0 - 1 - cc))); const float* q = kvb + (size_t)(cc * 2 + 0) * 4096;
          const f32x4 a = *(const f32x4*)q, bq = *(const f32x4*)(q + 4);
          sf[0] += wgt * a.x; sf[1] += wgt * a.y; sf[2] += wgt * a.z; sf[3] += wgt * a.w; sf[4] += wgt * bq.x; sf[5] += wgt * bq.y; sf[6] += wgt * bq.z; sf[7] += wgt * bq.w; }
      for (int cc = c1 + 1; cc < NCH; ++cc) { const float wgt = __builtin_amdgcn_exp2f(lgb * (float)(RC * (cc - c1 - 1))); const float* q = kvb + (size_t)(cc * 2 + 1) * 4096;
          const f32x4 a = *(const f32x4*)q, bq = *(const f32x4*)(q + 4);
          sb[0] += wgt * a.x; sb[1] += wgt * a.y; sb[2] += wgt * a.z; sb[3] += wgt * a.w; sb[4] += wgt * bq.x; sb[5] += wgt * bq.y; sb[6] += wgt * bq.z; sb[7] += wgt * bq.w; }
      float sf1[8], sb0[8];
      { const float gf = __builtin_amdgcn_exp2f(lgf * (float)RC), gb = __builtin_amdgcn_exp2f(lgb * (float)RC);
        const float* qf_ = kvb + (size_t)(c0 * 2 + 0) * 4096; const float* qb_ = kvb + (size_t)(c1 * 2 + 1) * 4096;
        const f32x4 a = *(const f32x4*)qf_, a2 = *(const f32x4*)(qf_ + 4), c = *(const f32x4*)qb_, c2 = *(const f32x4*)(qb_ + 4);
        const float kf[8] = {a.x, a.y, a.z, a.w, a2.x, a2.y, a2.z, a2.w}, kb[8] = {c.x, c.y, c.z, c.w, c2.x, c2.y, c2.z, c2.w};
#pragma unroll
        for (int e = 0; e < 8; ++e) { sf1[e] = gf * sf[e] + kf[e]; sb0[e] = gb * sb[e] + kb[e]; } }
      const int cho = (dk >> 3), bo = (dk & 7) * 2;
#pragma unroll
      for (int e = 0; e < 8; ++e) { const int dv = dv8 + e; const int off = k_off(dv, cho) + bo;
          *(LAS unsigned short*)(lds + 0 * R2_CH + R2_SF + off) = (unsigned short)f2bf(sf[e]);  *(LAS unsigned short*)(lds + 0 * R2_CH + R2_SB + off) = (unsigned short)f2bf(sb0[e]);
          *(LAS unsigned short*)(lds + 1 * R2_CH + R2_SF + off) = (unsigned short)f2bf(sf1[e]); *(LAS unsigned short*)(lds + 1 * R2_CH + R2_SB + off) = (unsigned short)f2bf(sb[e]); }
    }
    const int w = F.wave, lane = F.lane, qc = lane & 31, hh = lane >> 5, j = w >> 2, qt = w & 3;
    const int n = 32 * qt + qc, pos = (c0 + j) * RC + n, tok = b * SEQ + pos;
    bf16x8 qf[4];
    { const bf16* qp = F.PROJ() + (size_t)tok * PW + C_RQ + h * HD + 8 * hh;
      v4u raw[4];
#pragma unroll
      for (int s = 0; s < 4; ++s) raw[s] = *(const v4u*)(qp + 16 * s);
#pragma unroll
      for (int s = 0; s < 2; ++s) {
          const float* cp_ = F.COS() + pos * 32 + 16 * s + 8 * hh; const float* sp_ = F.SIN() + pos * 32 + 16 * s + 8 * hh;
          const f32x4 cA = *(const f32x4*)cp_, cB = *(const f32x4*)(cp_ + 4), sA = *(const f32x4*)sp_, sB = *(const f32x4*)(sp_ + 4);
          const float cs[8] = {cA.x, cA.y, cA.z, cA.w, cB.x, cB.y, cB.z, cB.w}, sn[8] = {sA.x, sA.y, sA.z, sA.w, sB.x, sB.y, sB.z, sB.w};
          const v4u a = raw[s], bq = raw[s + 2];
          const float t1[8] = {bf_lo(a.x), bf_hi(a.x), bf_lo(a.y), bf_hi(a.y), bf_lo(a.z), bf_hi(a.z), bf_lo(a.w), bf_hi(a.w)};
          const float t2[8] = {bf_lo(bq.x), bf_hi(bq.x), bf_lo(bq.y), bf_hi(bq.y), bf_lo(bq.z), bf_hi(bq.z), bf_lo(bq.w), bf_hi(bq.w)};
          float o1[8], o2[8];
#pragma unroll
          for (int e = 0; e < 8; ++e) { o1[e] = t1[e] * cs[e] - t2[e] * sn[e]; o2[e] = t1[e] * sn[e] + t2[e] * cs[e]; }
          qf[s] = __builtin_bit_cast(bf16x8, pack8(o1, 1.f)); qf[s + 2] = __builtin_bit_cast(bf16x8, pack8(o2, 1.f)); } }
    LDS_WAIT(); __syncthreads();
    const LAS unsigned char* cb = lds + j * R2_CH;
    f32x16 Y[2];
#pragma unroll
    for (int i = 0; i < 16; ++i) { Y[0][i] = 0.f; Y[1][i] = 0.f; }
    const int i16 = lane & 15, q4 = i16 >> 2, p4 = i16 & 3, blk = (lane >> 4) & 1;
#pragma unroll
    for (int t = 0; t < 4; ++t) {
        f32x16 S;
#pragma unroll
        for (int i = 0; i < 16; ++i) S[i] = 0.f;
#pragma unroll
        for (int s = 0; s < 4; ++s) { const bf16x8 a = *(const LAS bf16x8*)(cb + R2_K + k_off(32 * t + qc, 2 * s + hh)); S = MFMA32(a, qf[s], S); }
#pragma unroll
        for (int i = 0; i < 16; ++i) { const int m = 32 * t + crow(i, hh); const int dd = n - m;
            const float dec = __builtin_amdgcn_exp2f((dd >= 0 ? lgf : -lgb) * (float)dd); S[i] *= dec; }
#pragma unroll
        for (int s2 = 0; s2 < 2; ++s2) {
            v4u pw; pw.x = cvtpk(S[8 * s2 + 0], S[8 * s2 + 1]); pw.y = cvtpk(S[8 * s2 + 2], S[8 * s2 + 3]); pw.z = cvtpk(S[8 * s2 + 4], S[8 * s2 + 5]); pw.w = cvtpk(S[8 * s2 + 6], S[8 * s2 + 7]);
            const bf16x8 pb = __builtin_bit_cast(bf16x8, pw);
            const int rlo = 32 * t + 16 * s2 + 4 * hh + q4;
#pragma unroll
            for (int dt = 0; dt < 2; ++dt) { const int ch = 4 * dt + 2 * blk + (p4 >> 1);
                const s16x4 lo = vtr(cb + R2_V + v_off(rlo, ch) + (p4 & 1) * 8), hi = vtr(cb + R2_V + v_off(rlo + 8, ch) + (p4 & 1) * 8);
                Y[dt] = MFMA32(__builtin_shufflevector(lo, hi, 0, 1, 2, 3, 4, 5, 6, 7), pb, Y[dt]); }
        }
        __builtin_amdgcn_sched_barrier(0);
    }
    const float qdf = __builtin_amdgcn_exp2f(lgf * (float)(n + 1)), qdb = __builtin_amdgcn_exp2f(lgb * (float)(RC - n));
#pragma unroll
    for (int dir = 0; dir < 2; ++dir) {
        const float qd = dir ? qdb : qdf;
#pragma unroll
        for (int dt = 0; dt < 2; ++dt) { f32x16 T;
#pragma unroll
            for (int i = 0; i < 16; ++i) T[i] = 0.f;
#pragma unroll
            for (int s = 0; s < 4; ++s) { const bf16x8 a = *(const LAS bf16x8*)(cb + (dir ? R2_SB : R2_SF) + k_off(32 * dt + qc, 2 * s + hh)); T = MFMA32(a, qf[s], T); }
#pragma unroll
            for (int i = 0; i < 16; ++i) Y[dt][i] += qd * T[i]; }
    }
    float ss = 0.f;
#pragma unroll
    for (int i = 0; i < 16; ++i) ss += Y[0][i] * Y[0][i] + Y[1][i] * Y[1][i];
    ss += __shfl_xor(ss, 32);
    const float rs = 1.f / sqrtf(ss * (1.f / 64.f) + EPS);
    const bf16* gp = F.PROJ() + (size_t)tok * PW + C_RG + h * HD + 4 * hh;
    bf16* op = F.MIX() + (size_t)tok * D + 512 + h * HD + 4 * hh;
#pragma unroll
    for (int dt = 0; dt < 2; ++dt)
#pragma unroll
        for (int g = 0; g < 4; ++g) { const v2u gw = *(const v2u*)(gp + 32 * dt + 8 * g);
            const float gg[4] = {bf_lo(gw.x), bf_hi(gw.x), bf_lo(gw.y), bf_hi(gw.y)}; float y[4];
#pragma unroll
            for (int e = 0; e < 4; ++e) y[e] = Y[dt][4 * g + e] * rs * (gg[e] / (1.f + __expf(-gg[e])));
            v2u wv; wv.x = cvtpk(y[0], y[1]); wv.y = cvtpk(y[2], y[3]); *(v2u*)(op + 32 * dt + 8 * g) = wv; }
}
__device__ __forceinline__ void ret_kv_phase(Frame& F) { for (int u = F.vcu; u < R1_UNITS; u += F.G) ret_kv_unit(F, u); __syncthreads(); }
__device__ __forceinline__ void ret_out_phase(Frame& F) { for (int u = F.vcu; u < R2_UNITS; u += F.G) ret_out_unit(F, u); __syncthreads(); }
}

__device__ __forceinline__ void ret_naive(Frame& F) {
    const long gt = (long)F.vcu * 512 + F.tid, NGT = (long)F.G * 512;
    const long total = (long)NB * NH * SEQ;
    for (long u = gt; u < total; u += NGT) {
        const int n = (int)(u & (SEQ - 1)), h = (int)((u >> 11) & 7), b = (int)(u >> 14);
        const float lgf = -__expf(F.dec_f()[h]) * 1.4426950408889634f, lgb = -__expf(F.dec_b()[h]) * 1.4426950408889634f;
        float q[64]; load_row64(F.PROJ() + (size_t)(b * SEQ + n) * PW + C_RQ + h * HD, q);
        float acc[64];
#pragma unroll
        for (int i = 0; i < 64; ++i) acc[i] = 0.f;
        for (int m = 0; m < SEQ; ++m) {
            const size_t row = (size_t)(b * SEQ + m) * PW;
            float kv[64]; load_row64(F.PROJ() + row + C_RK + h * HD, kv);
            float s = 0.f;
#pragma unroll
            for (int i = 0; i < 64; ++i) s += q[i] * kv[i];
            const float dec = (m <= n) ? exp2f(lgf * (float)(n - m)) : exp2f(lgb * (float)(m - n));
            s *= dec;
            load_row64(F.PROJ() + row + C_RV + h * HD, kv);
#pragma unroll
            for (int i = 0; i < 64; ++i) acc[i] += s * kv[i];
        }
        float ss = 0.f;
#pragma unroll
        for (int i = 0; i < 64; ++i) ss += acc[i] * acc[i];
        const float rs = 1.f / sqrtf(ss * (1.f / 64.f) + EPS);
        float g[64]; load_row64(F.PROJ() + (size_t)(b * SEQ + n) * PW + C_RG + h * HD, g);
        bf16* o = F.MIX() + (size_t)(b * SEQ + n) * D + 512 + h * HD;
        float y[64];
#pragma unroll
        for (int i = 0; i < 64; ++i) { const float gg = g[i]; y[i] = acc[i] * rs * (gg / (1.f + __expf(-gg))); }
#pragma unroll
        for (int c = 0; c < 8; ++c) { v4u w; w.x = pk2(y[8 * c], y[8 * c + 1]); w.y = pk2(y[8 * c + 2], y[8 * c + 3]); w.z = pk2(y[8 * c + 4], y[8 * c + 5]); w.w = pk2(y[8 * c + 6], y[8 * c + 7]); *(v4u*)(o + 8 * c) = w; }
    }
}
__device__ __forceinline__ void attn_combine(Frame& F) {
    const int gw = F.vcu * NWAVES + F.wave, NGW = F.G * NWAVES;
    for (int tok = gw; tok < M; tok += NGW) {
        const int h = F.lane >> 3;
        const float l0 = F.ATTL()[((size_t)0 * M + tok) * NH + h], l1 = F.ATTL()[((size_t)1 * M + tok) * NH + h], l2 = F.ATTL()[((size_t)2 * M + tok) * NH + h];
        const float mx = fmaxf(l0, fmaxf(l1, l2)); const float e0 = __expf(l0 - mx), e1 = __expf(l1 - mx), e2 = __expf(l2 - mx); const float inv = 1.f / (e0 + e1 + e2);
        const float w0 = e0 * inv, w1 = e1 * inv, w2 = e2 * inv;
        const v4u a = *(const v4u*)(F.ATTO() + ((size_t)0 * M + tok) * 512 + 8 * F.lane), b = *(const v4u*)(F.ATTO() + ((size_t)1 * M + tok) * 512 + 8 * F.lane), c = *(const v4u*)(F.ATTO() + ((size_t)2 * M + tok) * 512 + 8 * F.lane);
        float o[8];
        o[0] = w0 * bf_lo(a.x) + w1 * bf_lo(b.x) + w2 * bf_lo(c.x); o[1] = w0 * bf_hi(a.x) + w1 * bf_hi(b.x) + w2 * bf_hi(c.x);
        o[2] = w0 * bf_lo(a.y) + w1 * bf_lo(b.y) + w2 * bf_lo(c.y); o[3] = w0 * bf_hi(a.y) + w1 * bf_hi(b.y) + w2 * bf_hi(c.y);
        o[4] = w0 * bf_lo(a.z) + w1 * bf_lo(b.z) + w2 * bf_lo(c.z); o[5] = w0 * bf_hi(a.z) + w1 * bf_hi(b.z) + w2 * bf_hi(c.z);
        o[6] = w0 * bf_lo(a.w) + w1 * bf_lo(b.w) + w2 * bf_lo(c.w); o[7] = w0 * bf_hi(a.w) + w1 * bf_hi(b.w) + w2 * bf_hi(c.w);
        float ss = 0.f;
#pragma unroll
        for (int i = 0; i < 8; ++i) ss += o[i] * o[i];
        const float rs = 1.f / sqrtf(wave_sum(ss) * (1.f / 512.f) + EPS);
        v4u w; w.x = pk2(o[0] * rs, o[1] * rs); w.y = pk2(o[2] * rs, o[3] * rs); w.z = pk2(o[4] * rs, o[5] * rs); w.w = pk2(o[6] * rs, o[7] * rs);
        *(v4u*)(F.MIX() + (size_t)tok * D + 8 * F.lane) = w;
    }
}
__device__ __forceinline__ void router(Frame& F) {
    LAS int* s_cls = (LAS int*)(F.lds + RT_OFF); LAS float* s_glo = (LAS float*)(F.lds + RT_OFF + 256); LAS float* s_ghi = (LAS float*)(F.lds + RT_OFF + 512);
    LAS int* s_base = (LAS int*)(F.lds + RT_OFF + 768);
    LAS f32x4* wl = (LAS f32x4*)(F.lds + RING_OFF);
    { const float* rgw_ = F.rgw(); const float* rew_ = F.rew(); const float* gf_ = F.g_ffn();
    for (int i = F.tid; i < 5 * D; i += NWAVES * 64) { const int m = i >> 10, k = i & (D - 1);
        const f32x4 w = (m == 0) ? *(const f32x4*)(rgw_ + (size_t)k * 4) : *(const f32x4*)(rew_ + ((size_t)(m - 1) * D + k) * 4);
        wl[i] = w * gf_[k]; } }
    LDS_WAIT(); __syncthreads();
    const float* h1 = F.out; const float* rgb_ = F.rgb(); const float* reb_ = F.reb();
    for (int blk = F.vcu; blk < M / 64; blk += F.G) {
#pragma unroll 1
        for (int tb = 0; tb < 2; ++tb) {
            f32x4 v[4][4]; float ssq[4];
#pragma unroll
            for (int t = 0; t < 4; ++t) { const int tok = blk * 64 + F.wave * 8 + tb * 4 + t; const GAS f32x4* hr = (const GAS f32x4*)(h1 + (size_t)tok * D) + F.lane;
#pragma unroll
                for (int j = 0; j < 4; ++j) v[t][j] = hr[64 * j]; }
#pragma unroll
            for (int t = 0; t < 4; ++t) { float s = 0.f;
#pragma unroll
                for (int j = 0; j < 4; ++j) s += (v[t][j].x * v[t][j].x + v[t][j].y * v[t][j].y) + (v[t][j].z * v[t][j].z + v[t][j].w * v[t][j].w);
                ssq[t] = s; }
#pragma unroll
            for (int o = 1; o < 64; o <<= 1) {
#pragma unroll
                for (int t = 0; t < 4; ++t) ssq[t] += __shfl_xor(ssq[t], o); }
            float gl[4][4];
#pragma unroll
            for (int t = 0; t < 4; ++t) { const int tok = blk * 64 + F.wave * 8 + tb * 4 + t; const float rstd = 1.f / sqrtf(ssq[t] * (1.f / D) + EPS);
                GAS unsigned long long* o8 = (GAS unsigned long long*)(F.XN() + (size_t)tok * D) + F.lane;
#pragma unroll
                for (int j = 0; j < 4; ++j) { v[t][j] = v[t][j] * rstd; o8[64 * j] = (unsigned long long)pk2(v[t][j].x, v[t][j].y) | ((unsigned long long)pk2(v[t][j].z, v[t][j].w) << 32); }
#pragma unroll
                for (int e = 0; e < 4; ++e) gl[t][e] = 0.f; }
#pragma unroll
            for (int j = 0; j < 4; ++j)
#pragma unroll
                for (int e = 0; e < 4; ++e) { const f32x4 w = wl[4 * F.lane + 256 * j + e];
#pragma unroll
                    for (int t = 0; t < 4; ++t) { gl[t][0] += v[t][j][e] * w.x; gl[t][1] += v[t][j][e] * w.y; gl[t][2] += v[t][j][e] * w.z; gl[t][3] += v[t][j][e] * w.w; } }
#pragma unroll
            for (int o = 1; o < 64; o <<= 1) {
#pragma unroll
                for (int t = 0; t < 4; ++t)
#pragma unroll
                    for (int e = 0; e < 4; ++e) gl[t][e] += __shfl_xor(gl[t][e], o); }
            int gsel[4]; float pgv[4]; float el[4][4];
#pragma unroll
            for (int t = 0; t < 4; ++t) {
#pragma unroll
                for (int e = 0; e < 4; ++e) gl[t][e] += rgb_[e];
                int g = 0; float gm = gl[t][0];
#pragma unroll
                for (int e = 1; e < 4; ++e) if (gl[t][e] > gm) { gm = gl[t][e]; g = e; }
                gsel[t] = g; pgv[t] = 1.f / (__expf(gl[t][0] - gm) + __expf(gl[t][1] - gm) + __expf(gl[t][2] - gm) + __expf(gl[t][3] - gm));
#pragma unroll
                for (int e = 0; e < 4; ++e) el[t][e] = 0.f; }
#pragma unroll
            for (int t = 0; t < 4; ++t) { const LAS f32x4* we = wl + (1 + gsel[t]) * D;
#pragma unroll
                for (int j = 0; j < 4; ++j)
#pragma unroll
                    for (int e = 0; e < 4; ++e) { const f32x4 w = we[4 * F.lane + 256 * j + e];
                        el[t][0] += v[t][j][e] * w.x; el[t][1] += v[t][j][e] * w.y; el[t][2] += v[t][j][e] * w.z; el[t][3] += v[t][j][e] * w.w; } }
#pragma unroll
            for (int o = 1; o < 64; o <<= 1) {
#pragma unroll
                for (int t = 0; t < 4; ++t)
#pragma unroll
                    for (int e = 0; e < 4; ++e) el[t][e] += __shfl_xor(el[t][e], o); }
#pragma unroll
            for (int t = 0; t < 4; ++t) { const int g = gsel[t], tl = F.wave * 8 + tb * 4 + t;
#pragma unroll
                for (int e = 0; e < 4; ++e) el[t][e] += reb_[g * 4 + e];
                int i1 = 0; float v1 = el[t][0];
#pragma unroll
                for (int e = 1; e < 4; ++e) if (el[t][e] > v1) { v1 = el[t][e]; i1 = e; }
                int i2 = -1; float v2 = -3.0e38f;
#pragma unroll
                for (int e = 0; e < 4; ++e) if (e != i1 && el[t][e] > v2) { v2 = el[t][e]; i2 = e; }
                const float p2 = 1.f / (1.f + __expf(v1 - v2)), p1 = 1.f - p2;
                const int lo = i1 < i2 ? i1 : i2, hi = i1 < i2 ? i2 : i1;
                const float glo = pgv[t] * (i1 < i2 ? p1 : p2), ghi = pgv[t] * (i1 < i2 ? p2 : p1);
                const int pidx = lo == 0 ? hi - 1 : (lo == 1 ? 1 + hi : 5);
                if (F.lane == 0) { s_cls[tl] = g * 6 + pidx; s_glo[tl] = glo; s_ghi[tl] = ghi; } }
        }
        LDS_WAIT(); __syncthreads();
        if (F.tid < NCLS) { int n = 0;
            for (int i = 0; i < 64; ++i) n += (s_cls[i] == F.tid) ? 1 : 0;
            int base = 0; if (n > 0) base = (int)__hip_atomic_fetch_add((unsigned*)(F.ctl + CW_CLS + 64 * F.tid), (unsigned)n, RLX_AGENT);
            s_base[F.tid] = base; }
        LDS_WAIT(); __syncthreads();
        if (F.tid < 64) { const int c = s_cls[F.tid]; int rank = 0;
            for (int i = 0; i < F.tid; ++i) rank += (s_cls[i] == c) ? 1 : 0;
            ListEnt e; e.tok = blk * 64 + F.tid; e.glo = s_glo[F.tid]; e.ghi = s_ghi[F.tid]; e.pad = 0;
            F.LIST()[(size_t)c * LCAP + s_base[c] + rank] = e; }
        LDS_WAIT(); __syncthreads();
    }
}
__device__ __forceinline__ void cls_experts(int cls, int& elo, int& ehi) { const int g = cls / 6, p = cls % 6; const int lo = p < 3 ? 0 : (p < 5 ? 1 : 2), hi = p < 3 ? p + 1 : (p < 5 ? p - 1 : 3); elo = 4 * g + lo; ehi = 4 * g + hi; }
__device__ __forceinline__ void moe_tab_build(Frame& F) {
    LAS int* tab = (LAS int*)(F.lds + MOETAB_OFF);
    if (F.tid == 0) { int t = 0;
        for (int c = 0; c < NCLS; ++c) { const int n = (int)__hip_atomic_load((unsigned*)(F.ctl + CW_CLS + 64 * c), RLX_AGENT); tab[c] = n; tab[32 + c] = t; t += (n + 255) >> 8; }
        tab[32 + NCLS] = t; }
    LDS_WAIT(); __syncthreads();
}
struct MoeOrderBase {
    const LAS int* tab; int G, c, ncol, nunits;
    __device__ __forceinline__ bool decode(int i, pg8::Unit& u) const {
        const long L = (long)i * G + c; if (L >= nunits) return false;
        const int wgid = pg8::xcd_remap((int)L, nunits);
        const int rt = wgid / ncol; u.pm = rt; u.pn = wgid % ncol;
        int cls = 0;
        for (int k = 1; k < NCLS; ++k) if (rt >= tab[32 + k]) cls = k;
        u.x0 = cls; u.x1 = tab[cls] - (rt - tab[32 + cls]) * 256;
        return true;
    }
};
struct UpOrder : MoeOrderBase {
    static constexpr bool GATHER = true;
    const bf16* HN; const bf16* W1T; const bf16* W3T; const ListEnt* list;
    __device__ __forceinline__ bool next(int i, pg8::Unit& u) const { return decode(i, u); }
    __device__ __forceinline__ const char* a_base(const pg8::Unit&) const { return (const char*)HN; }
    __device__ __forceinline__ void a_voff(const pg8::Unit& u, const int (&R)[2], const int (&C)[2], unsigned (&v)[2][2]) const {
        const int slot0 = (u.pm - tab[32 + u.x0]) * 256;
#pragma unroll
        for (int h = 0; h < 2; ++h)
#pragma unroll
            for (int i = 0; i < 2; ++i) { const int r = h * 128 + R[i]; int tok = 0; if (r < u.x1) tok = list[(size_t)u.x0 * LCAP + slot0 + r].tok;
                v[h][i] = (unsigned)(tok * D + C[i]) * 2u; }
    }
    __device__ __forceinline__ const char* b_base(const pg8::Unit& u, int half, int kt) const {
        int elo, ehi; cls_experts(u.x0, elo, ehi); const int e = u.pn < 4 ? elo : ehi;
        const bf16* W = half ? W3T : W1T;
        return (const char*)W + ((size_t)(e * FF + (u.pn & 3) * 128) * D + (size_t)kt * 64) * 2;
    }
};
struct DownOrder : MoeOrderBase {
    static constexpr bool GATHER = false;
    const bf16* HID; const bf16* W2T;
    __device__ __forceinline__ bool next(int i, pg8::Unit& u) const { return decode(i, u); }
    __device__ __forceinline__ const char* a_base(const pg8::Unit& u) const { return (const char*)HID + (size_t)u.pm * 256 * D * 2; }
    __device__ __forceinline__ void a_voff(const pg8::Unit&, const int (&R)[2], const int (&C)[2], unsigned (&v)[2][2]) const {
#pragma unroll
        for (int h = 0; h < 2; ++h)
#pragma unroll
            for (int i = 0; i < 2; ++i) v[h][i] = (unsigned)((h * 128 + R[i]) * D + C[i]) * 2u;
    }
    __device__ __forceinline__ const char* b_base(const pg8::Unit& u, int half, int kt) const {
        int elo, ehi; cls_experts(u.x0, elo, ehi); const int e = kt < 8 ? elo : ehi;
        return (const char*)W2T + ((size_t)(e * D + u.pn * 256 + half * 128) * FF + (size_t)(kt & 7) * 64) * 2;
    }
};
struct EpiUp {
    static constexpr bool PERM = true;
    bf16* HID; const ListEnt* list; const LAS int* tab;
    __device__ __forceinline__ void operator()(const f32x4 (&acc)[2][2][4][2], const pg8::Unit& u, int wr, int wc, int fr, int fq) const {
        const int slot0 = (u.pm - tab[32 + u.x0]) * 256; const bool usehi = u.pn >= 4;
#pragma unroll
        for (int ai = 0; ai < 2; ++ai)
#pragma unroll
            for (int m = 0; m < 4; ++m) { const int r = ai * 128 + wr * 64 + m * 16 + fr;
                float gate = 0.f; if (r < u.x1) { const ListEnt* e = list + (size_t)u.x0 * LCAP + slot0 + r; gate = usehi ? e->ghi : e->glo; }
                const f32x4 a0 = acc[ai][0][m][0], a1 = acc[ai][0][m][1], b0 = acc[ai][1][m][0], b1 = acc[ai][1][m][1];
                float o[8];
#pragma unroll
                for (int j = 0; j < 4; ++j) { o[j] = a0[j] / (1.f + __expf(-a0[j])) * b0[j] * gate; o[4 + j] = a1[j] / (1.f + __expf(-a1[j])) * b1[j] * gate; }
                pg8::u32x4 w; w.x = pg8::cvt_pk_bf16(o[0], o[1]); w.y = pg8::cvt_pk_bf16(o[2], o[3]); w.z = pg8::cvt_pk_bf16(o[4], o[5]); w.w = pg8::cvt_pk_bf16(o[6], o[7]);
                *(pg8::u32x4*)(HID + (size_t)(u.pm * 256 + r) * D + u.pn * 128 + wc * 32 + 8 * fq) = w; }
    }
};
struct EpiDown {
    static constexpr bool PERM = false;
    float* out; const ListEnt* list; const LAS int* tab;
    __device__ __forceinline__ void operator()(const f32x4 (&acc)[2][2][4][2], const pg8::Unit& u, int wr, int wc, int fr, int fq) const {
        const int slot0 = (u.pm - tab[32 + u.x0]) * 256; const int col0 = u.pn * 256 + wc * 32 + 4 * fq;
#pragma unroll
        for (int ai = 0; ai < 2; ++ai)
#pragma unroll
            for (int m = 0; m < 4; ++m) { const int r = ai * 128 + wr * 64 + m * 16 + fr;
                if (r < u.x1) { const int tok = list[(size_t)u.x0 * LCAP + slot0 + r].tok; float* rowp = out + (size_t)tok * D + col0;
#pragma unroll
                    for (int bj = 0; bj < 2; ++bj)
#pragma unroll
                        for (int n = 0; n < 2; ++n) { const f32x4 h = *(const f32x4*)(rowp + bj * 128 + n * 16); *(f32x4*)(rowp + bj * 128 + n * 16) = h + acc[ai][bj][m][n]; } }
                asm volatile("" ::: "memory"); }
    }
};
__device__ __forceinline__ void final_norm(Frame& F) {
    const float* gfin_ = F.g_fin();
    const int gw = F.vcu * NWAVES + F.wave, NGW = F.G * NWAVES;
    for (int m = gw; m < M; m += NGW) {
        GAS f32x4* xr = (GAS f32x4*)(F.out + (size_t)m * D) + F.lane;
        f32x4 v[4]; float s = 0.f;
#pragma unroll
        for (int j = 0; j < 4; ++j) { v[j] = xr[64 * j]; s += (v[j].x * v[j].x + v[j].y * v[j].y) + (v[j].z * v[j].z + v[j].w * v[j].w); }
        const float rstd = 1.f / sqrtf(wave_sum(s) * (1.f / D) + EPS);
#pragma unroll
        for (int j = 0; j < 4; ++j) { const f32x4 g = *(const f32x4*)(gfin_ + 4 * F.lane + 256 * j); xr[64 * j] = v[j] * rstd * g; }
    }
}

constexpr int NPHASE = 9;
struct Args { const float* in[17]; float* out; unsigned char* ws; int ph_lo, ph_hi; };
__global__ void __launch_bounds__(NWAVES * 64, 2) hybrid_fwd(Args args) {
    extern __shared__ __attribute__((aligned(16))) unsigned char lds[];
    Frame F;
    F.lds = (LAS unsigned char*)lds;
    F.MISC = (volatile LAS unsigned*)(F.lds + MISC_OFF);
    F.tid = threadIdx.x; F.lane = F.tid & 63; F.wave = __builtin_amdgcn_readfirstlane(F.tid >> 6);
    F.G = gridDim.x; { const int bx = blockIdx.x; F.vcu = (F.G % 8 == 0) ? (bx % 8) * (F.G / 8) + bx / 8 : bx; }
    unsigned char* ws = args.ws; F.ws = ws; F.out = args.out;
    F.ctl = (gu32*)(ws + WS_CTL);
    for (int u = F.tid; u < (LDS_BYTES - LDSCTL_OFF) / 4; u += NWAVES * 64) ((LAS unsigned*)(F.lds + LDSCTL_OFF))[u] = 0u;
    __syncthreads();
    if (F.tid < 17) { const unsigned long long p = (unsigned long long)args.in[F.tid]; volatile LAS unsigned* t = (volatile LAS unsigned*)(F.lds + PTAB_OFF) + 2 * F.tid; t[0] = (unsigned)p; t[1] = (unsigned)(p >> 32); }
    LDS_WAIT(); __syncthreads();
#if MK_PER_PHASE
#define GRID_BAR() do { } while (0)
#else
    XcdBarrier bar = xcd_barrier_post((unsigned*)(F.ctl + CW_BAR), F.MISC + 8);
#define GRID_BAR() xcd_barrier(bar)
#endif
    const int lo = args.ph_lo, hi = args.ph_hi;
#ifndef PHASE_MASK
#define PHASE_MASK 0x1ff
#endif
#define IN(k) (((PHASE_MASK >> (k)) & 1) && lo <= (k) && (k) < hi)
#define BOTH(k) (IN(k) && IN((k) + 1))

#ifndef REP_MASK
#define REP_MASK 0
#endif
#define RUNPH(k, BODY) do { if (IN(k)) { BODY(); if ((REP_MASK >> (k)) & 1) { GRID_BAR(); BODY(); } if (BOTH(k)) GRID_BAR(); } } while (0)
#define PH0() do { p0_prologue(F); } while (0)
#define PH1() do { pg8::DenseOrder S; S.init(F.XN(), F.WinT(), M, PW, D, D, F.G, (int)blockIdx.x); pg8::EpiBf16 E{F.PROJ(), PW}; \
        pg8::gemm_phase<pg8::EpiBf16, pg8::DenseOrder, true, true>(F.lds + RING_OFF, S, E, D, D); expert_convert_queue(F); } while (0)
#define PH2() do { mx::attn_phase(F); mx::ret_kv_phase(F); } while (0)
#define PH3() do { mx::ret_out_phase(F); attn_combine(F); } while (0)
#define PH4() do { pg8::DenseOrder S; S.init(F.MIX(), F.WoutT(), M, D, D, D, F.G, (int)blockIdx.x); pg8::EpiResF32 E{F.x(), F.out, D}; \
        pg8::gemm_phase<pg8::EpiResF32, pg8::DenseOrder, true, true>(F.lds + RING_OFF, S, E, D, D); } while (0)
#define PH5() do { router(F); } while (0)
#define PH6() do { moe_tab_build(F); const LAS int* tab = (const LAS int*)(F.lds + MOETAB_OFF); \
        UpOrder S; S.tab = tab; S.G = F.G; S.c = (int)blockIdx.x; S.ncol = 8; S.nunits = tab[32 + NCLS] * 8; S.HN = F.XN(); S.W1T = F.W1T(); S.W3T = F.W3T(); S.list = F.LIST(); \
        EpiUp E{F.HID(), F.LIST(), tab}; pg8::gemm_phase<EpiUp, UpOrder, true, true>(F.lds + RING_OFF, S, E, D, D); } while (0)
#define PH7() do { moe_tab_build(F); const LAS int* tab = (const LAS int*)(F.lds + MOETAB_OFF); \
        DownOrder S; S.tab = tab; S.G = F.G; S.c = (int)blockIdx.x; S.ncol = 4; S.nunits = tab[32 + NCLS] * 4; S.HID = F.HID(); S.W2T = F.W2T(); \
        EpiDown E{F.out, F.LIST(), tab}; pg8::gemm_phase<EpiDown, DownOrder, true, true>(F.lds + RING_OFF, S, E, FF, D); } while (0)
#define PH8() do { final_norm(F); } while (0)
    RUNPH(0, PH0); RUNPH(1, PH1); RUNPH(2, PH2); RUNPH(3, PH3); RUNPH(4, PH4); RUNPH(5, PH5); RUNPH(6, PH6); RUNPH(7, PH7); RUNPH(8, PH8);
#undef IN
#undef BOTH
}

extern "C" void kernel_launch(void* const* d_in, const int* in_sizes, int n_in, void* d_out, int out_size, void* d_ws, size_t ws_size, hipStream_t stream) {
    static int grid = 0;
    if (grid == 0) {
        if (n_in != 17 || in_sizes[0] != M * D || out_size != M * D || ws_size < WS_END) { fprintf(stderr, "kernel_launch: unexpected shapes (n_in %d, in0 %d, out %d, ws %zu)\n", n_in, n_in > 0 ? in_sizes[0] : -1, out_size, ws_size); grid = -1; return; }
        int dev = 0, cus = 0, per_cu = 0;
        if (hipGetDevice(&dev) != hipSuccess || hipDeviceGetAttribute(&cus, hipDeviceAttributeMultiprocessorCount, dev) != hipSuccess) { grid = -1; return; }
        if (hipFuncSetAttribute((const void*)hybrid_fwd, hipFuncAttributeMaxDynamicSharedMemorySize, LDS_BYTES) != hipSuccess) { fprintf(stderr, "kernel_launch: hipFuncSetAttribute failed\n"); grid = -1; return; }
        if (hipOccupancyMaxActiveBlocksPerMultiprocessor(&per_cu, (const void*)hybrid_fwd, NWAVES * 64, LDS_BYTES) != hipSuccess || per_cu < 1)
            fprintf(stderr, "kernel_launch: note: occupancy query reports %d workgroups per CU\n", per_cu);
        (void)hipGetLastError();
        grid = cus;
    }
    if (grid < 0) return;
    if (hipMemsetAsync((char*)d_ws + WS_CTL, 0, CTL_ZERO_BYTES, stream) != hipSuccess) return;
    Args a{};
    for (int i = 0; i < 17; ++i) a.in[i] = (const float*)d_in[i];
    a.out = (float*)d_out; a.ws = (unsigned char*)d_ws;
#if MK_PER_PHASE
    for (int p = 0; p < NPHASE; ++p) { a.ph_lo = p; a.ph_hi = p + 1; hipLaunchKernelGGL(hybrid_fwd, dim3(grid), dim3(NWAVES * 64), LDS_BYTES, stream, a); }
#else
    a.ph_lo = 0; a.ph_hi = NPHASE; hipLaunchKernelGGL(hybrid_fwd, dim3(grid), dim3(NWAVES * 64), LDS_BYTES, stream, a);
#endif
}
```

```cpp
#include <hip/hip_runtime.h>
#include <cstdio>
#include <cstdint>

#ifndef MK_PER_PHASE
#define MK_PER_PHASE 0
#endif

#define GAS __attribute__((address_space(1)))
#define LAS __attribute__((address_space(3)))
typedef unsigned short bf16;
typedef unsigned v4u __attribute__((ext_vector_type(4)));
typedef unsigned v2u __attribute__((ext_vector_type(2)));
typedef float f32x4 __attribute__((ext_vector_type(4)));
typedef float f32x2 __attribute__((ext_vector_type(2)));
typedef short bf16x8 __attribute__((ext_vector_type(8)));
typedef GAS unsigned gu32;
#define RLX_AGENT __ATOMIC_RELAXED, __HIP_MEMORY_SCOPE_AGENT
#define LDS_WAIT() asm volatile("s_waitcnt lgkmcnt(0)" ::: "memory")
#define VM_WAIT() asm volatile("s_waitcnt vmcnt(0)" ::: "memory")

constexpr int NB = 8, SEQ = 2048, D = 1024, M = NB * SEQ, PW = 3584, NH = 8, HD = 64;
constexpr int C_AQ = 0, C_AK = 512, C_AV = 1024, C_RQ = 1536, C_RK = 2048, C_RV = 2560, C_RG = 3072;
constexpr int NE = 16, FF = 512, NCLS = 24, LCAP = 16384;
constexpr float EPS = 1e-6f;
constexpr int RC = 128, NCH = SEQ / RC;

constexpr size_t MiB = 1u << 20;
constexpr size_t WS_CTL = 0, CTL_ZERO_BYTES = 1 * MiB;
constexpr size_t WS_COS = 1 * MiB, WS_SIN = WS_COS + 256 * 1024, WS_BIAS = WS_SIN + 256 * 1024;
constexpr size_t WS_WIN = 4 * MiB, WS_WOUT = 11 * MiB, WS_W1 = 13 * MiB, WS_W3 = 29 * MiB, WS_W2 = 45 * MiB;
constexpr size_t WS_XN = 61 * MiB;
constexpr size_t WS_PROJ = 93 * MiB;
constexpr size_t WS_MIX = 205 * MiB;
constexpr size_t WS_LIST = 237 * MiB;
constexpr size_t WS_END = 243 * MiB;
constexpr size_t DO_ATTO = 0, DO_ATTL = 48 * MiB;
constexpr int CW_TMO = 0, CW_CODE = 1, CW_BAR = 4096, CW_CLS = 16384;

constexpr int RING_OFF = 0, RING_BYTES = 131072;
constexpr int LDSCTL_OFF = RING_BYTES, MISC_OFF = LDSCTL_OFF + 320;
constexpr int MOETAB_OFF = LDSCTL_OFF + 1024;
constexpr int RT_OFF = LDSCTL_OFF + 2048;
constexpr int LDS_BYTES = 147456;
constexpr int NWAVES = 8;

struct ListEnt { int tok; float glo, ghi; int pad; };

__device__ __forceinline__ unsigned f2bf(float f) { unsigned u = __builtin_bit_cast(unsigned, f); return (u + 0x7fffu + ((u >> 16) & 1u)) >> 16; }
__device__ __forceinline__ unsigned pk2(float lo, float hi) { return f2bf(lo) | (f2bf(hi) << 16); }
__device__ __forceinline__ float bf_lo(unsigned w) { return __builtin_bit_cast(float, w << 16); }
__device__ __forceinline__ float bf_hi(unsigned w) { return __builtin_bit_cast(float, w & 0xffff0000u); }
__device__ __forceinline__ float wave_sum(float v) {
#pragma unroll
    for (int o = 1; o < 64; o <<= 1) v += __shfl_xor(v, o);
    return v;
}

constexpr float SC_HN = 8.f, SC_W = 64.f, SC_HID = 16.f;
__device__ __forceinline__ unsigned pk4_fp8(float a, float b, float c, float d) { int w = 0; w = __builtin_amdgcn_cvt_pk_fp8_f32(a, b, w, false); w = __builtin_amdgcn_cvt_pk_fp8_f32(c, d, w, true); return (unsigned)w; }
namespace pg8 {
#define PG8_LAS __attribute__((address_space(3)))
typedef unsigned short bf16_t;
typedef unsigned u32x4 __attribute__((ext_vector_type(4)));
typedef int v4i_t __attribute__((ext_vector_type(4)));
typedef int v8i_t __attribute__((ext_vector_type(8)));
constexpr int BM = 256, BK = 64, HALF = 128, HTB = HALF * BK * 2, STAGE_BYTES = 8 * HTB, NXCD = 8, WGM = 8;

__host__ __device__ __forceinline__ int lds_byte(int r, int c) { const int st = (r >> 4) * 2 + (c >> 5), rr = r & 15, cc = c & 31, ob = rr * 64 + cc * 2; return st * 1024 + (ob ^ (((ob >> 9) & 1) << 5)); }
__host__ __device__ __forceinline__ void stage_rc(int b, int& R, int& C) { const int st = b / 1024, sb = b % 1024, swz = sb ^ (((sb >> 9) & 1) << 5); R = (st >> 1) * 16 + swz / 64; C = (st & 1) * 32 + (swz % 64) / 2; }
__host__ __device__ __forceinline__ int perm32(int rho) { const int n = rho >> 4, i = rho & 15; return 8 * (i >> 2) + 4 * n + (i & 3); }

struct Unit { int pm, pn, x0, x1; };

__device__ __forceinline__ int xcd_remap(int L, int nwg) { const int q = nwg / NXCD, r = nwg % NXCD, xcd = L % NXCD, off = L / NXCD; return (xcd < r ? xcd * (q + 1) : r * (q + 1) + (xcd - r) * q) + off; }

struct DenseOrder {
    static constexpr bool GATHER = false;
    const bf16_t* A; const bf16_t* Bt; int ldA, ldB; int nM, nN, nwg, G, c;
    __device__ void init(const bf16_t* A_, const bf16_t* Bt_, int M_, int N_, int ldA_, int ldB_, int G_, int c_) { A = A_; Bt = Bt_; ldA = ldA_; ldB = ldB_; nM = M_ / BM; nN = N_ / BM; nwg = nM * nN; G = G_; c = c_; }
    __device__ __forceinline__ bool next(int i, Unit& u) const {
        const long L = (long)i * G + c; if (L >= nwg) return false;
        const int wgid = xcd_remap((int)L, nwg);
        const int nig = WGM * nN, gid = wgid / nig, fm = gid * WGM, gsz = (nM - fm) < WGM ? (nM - fm) : WGM;
        u.pm = fm + ((wgid % nig) % gsz); u.pn = (wgid % nig) / gsz; u.x0 = 0; u.x1 = 0; return true;
    }
    __device__ __forceinline__ const char* a_base(const Unit& u) const { return (const char*)A + (size_t)u.pm * BM * ldA * 2; }
    __device__ __forceinline__ void a_voff(const Unit&, const int (&R)[2], const int (&C)[2], unsigned (&v)[2][2]) const {
#pragma unroll
        for (int h = 0; h < 2; ++h)
#pragma unroll
            for (int i = 0; i < 2; ++i) v[h][i] = (unsigned)((h * HALF + R[i]) * ldA + C[i]) * 2u;
    }
    __device__ __forceinline__ const char* b_base(const Unit& u, int half, int kt) const { return (const char*)Bt + ((size_t)(u.pn * BM + half * HALF) * ldB + (size_t)kt * BK) * 2; }
};

__device__ __forceinline__ unsigned cvt_pk_bf16(float lo, float hi) { unsigned r; asm volatile("v_cvt_pk_bf16_f32 %0, %1, %2" : "=v"(r) : "v"(lo), "v"(hi)); return r; }

struct EpiBf16 {
    static constexpr bool PERM = true;
    bf16_t* O; int ldc;
    __device__ __forceinline__ void operator()(const f32x4 (&acc)[2][2][4][2], const Unit& u, int wr, int wc, int fr, int fq) const {
        const int row0 = u.pm * BM + wr * 64 + fr; const int col0 = u.pn * BM + wc * 32 + 8 * fq;
#pragma unroll
        for (int ai = 0; ai < 2; ++ai)
#pragma unroll
            for (int m = 0; m < 4; ++m) { bf16_t* rowp = O + (size_t)(row0 + ai * HALF + m * 16) * ldc + col0;
#pragma unroll
                for (int bj = 0; bj < 2; ++bj) { const f32x4 v0 = acc[ai][bj][m][0], v1 = acc[ai][bj][m][1];
                    u32x4 w; w.x = cvt_pk_bf16(v0[0], v0[1]); w.y = cvt_pk_bf16(v0[2], v0[3]); w.z = cvt_pk_bf16(v1[0], v1[1]); w.w = cvt_pk_bf16(v1[2], v1[3]);
                    *(u32x4*)(rowp + bj * HALF) = w; } }
    }
};
struct EpiResF32 {
    static constexpr bool PERM = false;
    const float* res; float* out; int ldc;
    __device__ __forceinline__ void operator()(const f32x4 (&acc)[2][2][4][2], const Unit& u, int wr, int wc, int fr, int fq) const {
        const int row0 = u.pm * BM + wr * 64 + fr, col0 = u.pn * BM + wc * 32 + 4 * fq;
#pragma unroll
        for (int ai = 0; ai < 2; ++ai)
#pragma unroll
            for (int m = 0; m < 4; ++m) { const size_t off = (size_t)(row0 + ai * HALF + m * 16) * ldc + col0;
#pragma unroll
                for (int bj = 0; bj < 2; ++bj)
#pragma unroll
                    for (int n = 0; n < 2; ++n) { const f32x4 r = *(const f32x4*)(res + off + bj * HALF + n * 16); *(f32x4*)(out + off + bj * HALF + n * 16) = r + acc[ai][bj][m][n]; }
                asm volatile("" ::: "memory"); }
    }
};

template <class Epi, class Sched, bool ALIGN_EPI, bool SP2, bool FP8 = false>
__device__ __forceinline__ void gemm_phase(PG8_LAS unsigned char* lds, const Sched& S, const Epi& E, const int ldB_bytes, const int nt) {
    const int tid = threadIdx.x, wid = __builtin_amdgcn_readfirstlane(tid >> 6), lane = tid & 63, wr = wid >> 2, wc = wid & 3, fr = lane & 15, fq = lane >> 4;
    int sR[2], sC[2]; unsigned voffB[2];
#pragma unroll
    for (int i = 0; i < 2; ++i) { stage_rc(tid * 16 + i * 8192, sR[i], sC[i]); const int Rb = Epi::PERM ? ((sR[i] & ~31) + perm32(sR[i] & 31)) : sR[i];
        voffB[i] = (unsigned)(Rb * ldB_bytes + sC[i] * 2); }
    const size_t kstep = (size_t)(BK * 2);
    const unsigned ldsw = (unsigned)wid * 1024u;
    const int aoff = lds_byte(wr * 64 + fr, fq * 8), boff = lds_byte(wc * 32 + fr, fq * 8);
    PG8_LAS unsigned char* ldsA = lds + aoff; PG8_LAS unsigned char* ldsB = lds + 4 * HTB + boff;
    asm volatile("" : "+v"(ldsA)); asm volatile("" : "+v"(ldsB));
#define PG8_SA(b, h) (((b) * 2 + (h)) * HTB)
#define PG8_SB(b, h) ((4 + (b) * 2 + (h)) * HTB)
#define PG8_STAGE(bufoff, gbase, voff) do { _Pragma("unroll") for (int _i = 0; _i < 2; ++_i) \
        __builtin_amdgcn_global_load_lds((const unsigned*)((const char*)(gbase) + (voff)[_i]), (PG8_LAS unsigned*)(lds + (bufoff) + ldsw + _i * 8192), 16, 0, 0); } while (0)
#define PG8_RDA(off) (*(const PG8_LAS v4i_t*)(ldsA + (off)))
#define PG8_RDB(off) (*(const PG8_LAS v4i_t*)(ldsB + (off)))
#define PG8_SBR(b, h) (((b) * 2 + (h)) * HTB)
#define PG8_LDA(dst, b, h) do { if constexpr (FP8) { _Pragma("unroll") for (int m = 0; m < 4; ++m) dst##8[m] = PG8_CAT(PG8_RDA(PG8_SA(b, h) + m * 2048), PG8_RDA(PG8_SA(b, h) + m * 2048 + 1024)); } \
        else { _Pragma("unroll") for (int m = 0; m < 4; ++m) _Pragma("unroll") for (int k = 0; k < 2; ++k) dst[m][k] = __builtin_bit_cast(bf16x8, PG8_RDA(PG8_SA(b, h) + m * 2048 + k * 1024)); } } while (0)
#define PG8_LDB(dst, b, h) do { if constexpr (FP8) { _Pragma("unroll") for (int n = 0; n < 2; ++n) dst##8[n] = PG8_CAT(PG8_RDB(PG8_SBR(b, h) + n * 2048), PG8_RDB(PG8_SBR(b, h) + n * 2048 + 1024)); } \
        else { _Pragma("unroll") for (int n = 0; n < 2; ++n) _Pragma("unroll") for (int k = 0; k < 2; ++k) dst[n][k] = __builtin_bit_cast(bf16x8, PG8_RDB(PG8_SBR(b, h) + n * 2048 + k * 1024)); } } while (0)
#define PG8_MMA(ai, bj, At, Bt) do { __builtin_amdgcn_s_setprio(1); \
        if constexpr (FP8) {   \
            asm volatile("s_nop 1\n\t" \
                "v_mfma_f32_16x16x128_f8f6f4 %0, %8, %10, %0\n\tv_mfma_f32_16x16x128_f8f6f4 %1, %9, %10, %1\n\t" \
                "v_mfma_f32_16x16x128_f8f6f4 %2, %8, %11, %2\n\tv_mfma_f32_16x16x128_f8f6f4 %3, %9, %11, %3\n\t" \
                "v_mfma_f32_16x16x128_f8f6f4 %4, %8, %12, %4\n\tv_mfma_f32_16x16x128_f8f6f4 %5, %9, %12, %5\n\t" \
                "v_mfma_f32_16x16x128_f8f6f4 %6, %8, %13, %6\n\tv_mfma_f32_16x16x128_f8f6f4 %7, %9, %13, %7" \
                : "+v"(acc[ai][bj][0][0]), "+v"(acc[ai][bj][0][1]), "+v"(acc[ai][bj][1][0]), "+v"(acc[ai][bj][1][1]), "+v"(acc[ai][bj][2][0]), "+v"(acc[ai][bj][2][1]), "+v"(acc[ai][bj][3][0]), "+v"(acc[ai][bj][3][1]) \
                : "v"(Bt##8[0]), "v"(Bt##8[1]), "v"(At##8[0]), "v"(At##8[1]), "v"(At##8[2]), "v"(At##8[3])); } \
        else { _Pragma("unroll") for (int m = 0; m < 4; ++m) _Pragma("unroll") for (int n = 0; n < 2; ++n) _Pragma("unroll") for (int k = 0; k < 2; ++k) \
            acc[ai][bj][m][n] = __builtin_amdgcn_mfma_f32_16x16x32_bf16(Bt[n][k], At[m][k], acc[ai][bj][m][n], 0, 0, 0); } \
        __builtin_amdgcn_s_setprio(0); } while (0)
#define PG8_CAT(x, y) __builtin_shufflevector((x), (y), 0, 1, 2, 3, 4, 5, 6, 7)
#define PG8_WAIT_V(n) asm volatile("s_waitcnt vmcnt(" #n ")" ::: "memory")
#define PG8_WAIT_L(n) asm volatile("s_waitcnt lgkmcnt(" #n ")" ::: "memory")
#define PG8_BAR __builtin_amdgcn_s_barrier()
#define PG8_SCHED __builtin_amdgcn_sched_barrier(0)
    Unit cur, nxt; int ui = 0;
    if (!S.next(0, cur)) return;
    f32x4 acc[2][2][4][2];
#pragma unroll
    for (int a = 0; a < 2; ++a)
#pragma unroll
        for (int b = 0; b < 2; ++b)
#pragma unroll
            for (int m = 0; m < 4; ++m)
#pragma unroll
                for (int n = 0; n < 2; ++n) acc[a][b][m][n] = (f32x4){0.f, 0.f, 0.f, 0.f};
    bf16x8 At[4][2], B0[2][2], B1[2][2];
    v8i_t At8[4], B08[2], B18[2];
    unsigned vA[2][2], vN[2][2];
    S.a_voff(cur, sR, sC, vA);
    const char* cA = S.a_base(cur);
    if constexpr (SP2) {
        PG8_STAGE(PG8_SB(0, 0), S.b_base(cur, 0, 0), voffB); PG8_STAGE(PG8_SB(0, 1), S.b_base(cur, 1, 0), voffB); PG8_STAGE(PG8_SA(0, 0), cA, vA[0]); PG8_STAGE(PG8_SA(0, 1), cA, vA[1]);
        if (wr == 1) PG8_BAR;
        PG8_WAIT_V(2); PG8_BAR;
        PG8_STAGE(PG8_SB(1, 0), S.b_base(cur, 0, 1), voffB); PG8_STAGE(PG8_SA(1, 0), cA + kstep, vA[0]); PG8_STAGE(PG8_SB(1, 1), S.b_base(cur, 1, 1), voffB);
        PG8_WAIT_V(6); PG8_BAR;
    } else {
        PG8_STAGE(PG8_SB(0, 0), S.b_base(cur, 0, 0), voffB); PG8_STAGE(PG8_SA(0, 0), cA, vA[0]); PG8_STAGE(PG8_SB(0, 1), S.b_base(cur, 1, 0), voffB); PG8_STAGE(PG8_SA(0, 1), cA, vA[1]);
        if (wr == 1) PG8_BAR;
        PG8_WAIT_V(4); PG8_BAR;
        PG8_STAGE(PG8_SB(1, 0), S.b_base(cur, 0, 1), voffB); PG8_STAGE(PG8_SA(1, 0), cA + kstep, vA[0]); PG8_STAGE(PG8_SB(1, 1), S.b_base(cur, 1, 1), voffB);
        PG8_WAIT_V(6); PG8_BAR;
    }
    for (;;) {
        const bool has_next = S.next(ui + 1, nxt);
        if (!has_next) nxt = cur;
        const char* nA = S.a_base(nxt);
        if (Sched::GATHER) { S.a_voff(nxt, sR, sC, vN); }
        else {
#pragma unroll
            for (int h = 0; h < 2; ++h)
#pragma unroll
                for (int i = 0; i < 2; ++i) vN[h][i] = vA[h][i]; }
#pragma unroll 1
        for (int t = 0; t < nt; t += 2) {
            const bool last = (t == nt - 2);
            const char* a1 = cA + (size_t)(t + 1) * kstep;
            const char* a2 = last ? nA : cA + (size_t)(t + 2) * kstep; const char* a3 = a2 + kstep;
            const Unit& bu = last ? nxt : cur; const int k2 = last ? 0 : t + 2, k3 = k2 + 1;
            const char* b20 = S.b_base(bu, 0, k2); const char* b21 = S.b_base(bu, 1, k2); const char* b30 = S.b_base(bu, 0, k3); const char* b31 = S.b_base(bu, 1, k3);
            unsigned v2[2][2];
#pragma unroll
            for (int h = 0; h < 2; ++h)
#pragma unroll
                for (int i = 0; i < 2; ++i) v2[h][i] = (Sched::GATHER && last) ? vN[h][i] : vA[h][i];
            if constexpr (SP2) {
            PG8_LDB(B0, 0, 0); PG8_LDB(B1, 0, 1); PG8_SCHED; PG8_LDA(At, 0, 0); PG8_STAGE(PG8_SA(1, 1), a1, vA[1]);
            PG8_WAIT_V(8); PG8_WAIT_L(0); PG8_BAR; PG8_MMA(0, 0, At, B0); PG8_MMA(0, 1, At, B1); PG8_BAR; PG8_SCHED;
            PG8_LDA(At, 0, 1); PG8_STAGE(PG8_SB(0, 0), b20, voffB); PG8_STAGE(PG8_SB(0, 1), b21, voffB); PG8_STAGE(PG8_SA(0, 0), a2, v2[0]);
            PG8_WAIT_V(8); PG8_WAIT_L(0); PG8_BAR; PG8_MMA(1, 0, At, B0); PG8_MMA(1, 1, At, B1); PG8_BAR; PG8_SCHED;
            PG8_LDB(B0, 1, 0); PG8_LDB(B1, 1, 1); PG8_SCHED; PG8_LDA(At, 1, 0); PG8_STAGE(PG8_SA(0, 1), a2, v2[1]);
            PG8_WAIT_V(8); PG8_WAIT_L(0); PG8_BAR; PG8_MMA(0, 0, At, B0); PG8_MMA(0, 1, At, B1); PG8_BAR; PG8_SCHED;
            PG8_LDA(At, 1, 1); PG8_STAGE(PG8_SB(1, 0), b30, voffB); PG8_STAGE(PG8_SB(1, 1), b31, voffB); PG8_STAGE(PG8_SA(1, 0), a3, v2[0]);
            PG8_WAIT_V(8); PG8_WAIT_L(0); PG8_BAR; PG8_MMA(1, 0, At, B0); PG8_MMA(1, 1, At, B1); PG8_BAR; PG8_SCHED;
            } else {
            PG8_LDB(B0, 0, 0); PG8_SCHED; PG8_LDA(At, 0, 0); PG8_STAGE(PG8_SA(1, 1), a1, vA[1]);
            PG8_WAIT_L(8); PG8_BAR; PG8_WAIT_L(0); PG8_MMA(0, 0, At, B0); PG8_BAR; PG8_SCHED;
            PG8_LDB(B1, 0, 1); PG8_STAGE(PG8_SB(0, 0), b20, voffB);
            PG8_BAR; PG8_WAIT_L(0); PG8_MMA(0, 1, At, B1); PG8_BAR;
            PG8_LDA(At, 0, 1); PG8_STAGE(PG8_SA(0, 0), a2, v2[0]);
            PG8_BAR; PG8_WAIT_L(0); PG8_MMA(1, 0, At, B0); PG8_BAR; PG8_SCHED;
            PG8_STAGE(PG8_SB(0, 1), b21, voffB);
            PG8_WAIT_V(6); PG8_BAR; PG8_MMA(1, 1, At, B1); PG8_BAR;
            PG8_LDB(B0, 1, 0); PG8_SCHED; PG8_LDA(At, 1, 0); PG8_STAGE(PG8_SA(0, 1), a2, v2[1]);
            PG8_WAIT_L(8); PG8_BAR; PG8_WAIT_L(0); PG8_MMA(0, 0, At, B0); PG8_BAR; PG8_SCHED;
            PG8_LDB(B1, 1, 1); PG8_STAGE(PG8_SB(1, 0), b30, voffB);
            PG8_BAR; PG8_WAIT_L(0); PG8_MMA(0, 1, At, B1); PG8_BAR;
            PG8_LDA(At, 1, 1); PG8_STAGE(PG8_SA(1, 0), a3, v2[0]);
            PG8_BAR; PG8_WAIT_L(0); PG8_MMA(1, 0, At, B0); PG8_BAR; PG8_SCHED;
            PG8_STAGE(PG8_SB(1, 1), b31, voffB);
            PG8_WAIT_V(6); PG8_BAR; PG8_MMA(1, 1, At, B1); PG8_BAR;
            }
        }
        if constexpr (ALIGN_EPI) { if (wr == 0) PG8_BAR; }
        if constexpr (FP8) asm volatile("s_nop 15\n\ts_nop 15" ::: "memory");
        E(acc, cur, wr, wc, fr, fq);
        if (!has_next) break;
#pragma unroll
        for (int a = 0; a < 2; ++a)
#pragma unroll
            for (int b = 0; b < 2; ++b)
#pragma unroll
                for (int m = 0; m < 4; ++m)
#pragma unroll
                    for (int n = 0; n < 2; ++n) acc[a][b][m][n] = (f32x4){0.f, 0.f, 0.f, 0.f};
        cur = nxt; cA = nA; ++ui;
#pragma unroll
        for (int h = 0; h < 2; ++h)
#pragma unroll
            for (int i = 0; i < 2; ++i) vA[h][i] = vN[h][i];
        if constexpr (ALIGN_EPI) { if (wr == 1) PG8_BAR; }
    }
    PG8_WAIT_V(0);
    if constexpr (!ALIGN_EPI) { if (wr == 0) PG8_BAR; }
    PG8_BAR;
#undef PG8_SA
#undef PG8_SB
#undef PG8_STAGE
#undef PG8_LDA
#undef PG8_RDA
#undef PG8_RDB
#undef PG8_SBR
#undef PG8_LDB
#undef PG8_MMA
#undef PG8_CAT
#undef PG8_WAIT_V
#undef PG8_WAIT_L
#undef PG8_BAR
#undef PG8_SCHED
}
}

#define XB_TMO      128
#define XB_XCNT(j)  (256  + 64 * (j))
#define XB_XSUB(j)  (1280 + 64 * (j))
#define XB_XGEN(j)  (2304 + 64 * (j))
#define XB_TOP      3328
#define XB_TOPGEN   3392
#define XCD_BAR_WORDS 3456
#define XB_SPIN_CAP (1u << 18)
__device__ __forceinline__ unsigned xb_ld(unsigned* p)              { return __hip_atomic_load(p, __ATOMIC_RELAXED, __HIP_MEMORY_SCOPE_AGENT); }
__device__ __forceinline__ unsigned xb_add(unsigned* p, unsigned v) { return __hip_atomic_fetch_add(p, v, __ATOMIC_RELAXED, __HIP_MEMORY_SCOPE_AGENT); }
__device__ __forceinline__ unsigned xb_xcc_id() { return (unsigned)__builtin_amdgcn_s_getreg((3 << 11) | 20) & 0xFu; }
#define XB_SPIN(cond, bar) do { unsigned _sp = 0; while (cond) { __builtin_amdgcn_s_sleep(1); \
    if ((++_sp & 255u) == 0u) { if (xb_ld(&(bar)[XB_TMO])) break; if (_sp > XB_SPIN_CAP) { atomicAdd(&(bar)[XB_TMO], 1u); break; } } } } while (0)
struct XcdBarrier { unsigned* bar; unsigned x; volatile LAS unsigned* st; };
__device__ __forceinline__ XcdBarrier xcd_barrier_post(unsigned* bar, volatile LAS unsigned* st) {
    XcdBarrier b; b.bar = bar; b.x = xb_xcc_id(); b.st = st;
    if (threadIdx.x == 0) (void)xb_add(&bar[XB_XCNT(b.x)], 1u);
    return b;
}
__device__ __forceinline__ void xcd_barrier_complete(unsigned* bar, unsigned x, unsigned& nloc, unsigned& nx) {
    const unsigned G = gridDim.x * gridDim.y * gridDim.z;
    unsigned sum, cnt, mine, sp = 0u;
    for (;;) {
        sum = 0u; cnt = 0u; mine = 0u;
#pragma unroll
        for (unsigned j = 0; j < 16; ++j) { const unsigned c = xb_ld(&bar[XB_XCNT(j)]); sum += c; cnt += (c > 0u) ? 1u : 0u; mine = (j == x) ? c : mine; }
        if (sum == G) break;
        __builtin_amdgcn_s_sleep(1);
        if ((++sp & 255u) == 0u) { if (xb_ld(&bar[XB_TMO])) break; if (sp > XB_SPIN_CAP) { atomicAdd(&bar[XB_TMO], 1u); break; } }
    }
    nloc = mine > 0u ? mine : 1u; nx = cnt > 0u ? cnt : 1u;
}
__device__ __forceinline__ void xcd_barrier(const XcdBarrier& b) {
    asm volatile("s_waitcnt vmcnt(0)" ::: "memory");
    __syncthreads();
    if (threadIdx.x == 0) {
        unsigned* bar = b.bar;
        __builtin_amdgcn_s_waitcnt(0);
        unsigned nloc = b.st[0], nx = b.st[1];
        if (nloc == 0u) { xcd_barrier_complete(bar, b.x, nloc, nx); b.st[0] = nloc; b.st[1] = nx; }
        const unsigned old = xb_add(&bar[XB_XSUB(b.x)], 1u);
        const unsigned gen = old / nloc;
        if (old + 1u == (gen + 1u) * nloc) {
            __builtin_amdgcn_fence(__ATOMIC_RELEASE, "agent");
            asm volatile("s_waitcnt vmcnt(0)" ::: "memory");
            const unsigned og = xb_add(&bar[XB_TOP], 1u);
            const unsigned tg = og / nx;
            if (og + 1u == (tg + 1u) * nx) xb_add(&bar[XB_TOPGEN], 1u);
            else XB_SPIN(xb_ld(&bar[XB_TOPGEN]) == tg, bar);
            __builtin_amdgcn_fence(__ATOMIC_ACQUIRE, "agent");
            xb_add(&bar[XB_XGEN(b.x)], 1u);
            asm volatile("s_waitcnt vmcnt(0)" ::: "memory");
        } else {
            XB_SPIN(xb_ld(&bar[XB_XGEN(b.x)]) == gen, bar);
            __builtin_amdgcn_fence(__ATOMIC_ACQUIRE, "agent");
            asm volatile("s_waitcnt vmcnt(0)" ::: "memory");
        }
    }
    __syncthreads();
}

constexpr int PTAB_OFF = LDSCTL_OFF + 512;
struct Frame {
    LAS unsigned char* lds;
    volatile LAS unsigned* MISC;
    gu32* ctl;
    int tid, lane, wave, vcu, G;
    unsigned char* ws; float* out;
    __device__ __forceinline__ const float* inp(int k) const { const volatile LAS unsigned* t = (const volatile LAS unsigned*)(lds + PTAB_OFF) + 2 * k;
        const unsigned lo = __builtin_amdgcn_readfirstlane(t[0]), hi = __builtin_amdgcn_readfirstlane(t[1]); return (const float*)(((unsigned long long)hi << 32) | lo); }
#define FIN(name, k) __device__ __forceinline__ const float* name() const { return inp(k); }
    FIN(x, 0) FIN(w_in, 1) FIN(w_out, 2) FIN(g_mix, 3) FIN(g_ffn, 4) FIN(g_fin, 5) FIN(g_att, 6) FIN(rel_bias, 7) FIN(dec_f, 8) FIN(dec_b, 9)
    FIN(rgw, 10) FIN(rgb, 11) FIN(rew, 12) FIN(reb, 13) FIN(w1, 14) FIN(w3, 15) FIN(w2, 16)
#undef FIN
#define FWS(T, name, off) __device__ __forceinline__ T* name() const { return (T*)(ws + (off)); }
    FWS(bf16, WinT, WS_WIN) FWS(bf16, WoutT, WS_WOUT) FWS(bf16, W1T, WS_W1) FWS(bf16, W3T, WS_W3) FWS(bf16, W2T, WS_W2)
    FWS(bf16, XN, WS_XN) FWS(bf16, PROJ, WS_PROJ) FWS(bf16, MIX, WS_MIX) FWS(bf16, HID, WS_PROJ)
    FWS(float, COS, WS_COS) FWS(float, SIN, WS_SIN) FWS(float, BIAS, WS_BIAS) FWS(float, KV, WS_XN) FWS(ListEnt, LIST, WS_LIST)
#undef FWS
    __device__ __forceinline__ bf16* ATTO() const { return (bf16*)((unsigned char*)out + DO_ATTO); }
    __device__ __forceinline__ float* ATTL() const { return (float*)((unsigned char*)out + DO_ATTL); }
};


typedef short s16x4_t __attribute__((ext_vector_type(4)));
typedef short v4i16e_t __attribute__((ext_vector_type(4)));
typedef __bf16 bf16x2e_t __attribute__((ext_vector_type(2)));
__device__ __forceinline__ unsigned cvtpk_e(float lo, float hi) { f32x2 v = {lo, hi}; bf16x2e_t b = __builtin_convertvector(v, bf16x2e_t); return __builtin_bit_cast(unsigned, b); }
__device__ __forceinline__ s16x4_t vtr_e(const LAS unsigned char* p) { return __builtin_bit_cast(s16x4_t, __builtin_amdgcn_ds_read_tr16_b64_v4i16((LAS v4i16e_t*)p)); }
__device__ __forceinline__ int v_off_e(int row, int ch) { return ((row >> 3) * 2 + (ch >> 2)) * 512 + (row & 7) * 64 + (ch & 3) * 16; }
template <bool FP8OUT> __device__ __forceinline__ void p0_transpose64(const float* W, int K, int N, bf16* WT, LAS unsigned char* img, int item, int lane, const float* ksc, int klim, float csc) {
    const int nblk = N / 64, kb = item / nblk, nb = item % nblk, k0 = 64 * kb, n0 = 64 * nb;
    const int kr = lane >> 4, n4 = (lane & 15) * 4;
    f32x4 v[16];
#pragma unroll
    for (int i = 0; i < 16; ++i) v[i] = *(const GAS f32x4*)(W + (size_t)(k0 + 4 * i + kr) * N + n0 + n4);
#pragma unroll
    for (int i = 0; i < 16; ++i) { const int k = 4 * i + kr; float s = csc; if (ksc && (k0 + k) < klim) s *= ksc[k0 + k];
        v2u w; w.x = cvtpk_e(v[i].x * s, v[i].y * s); w.y = cvtpk_e(v[i].z * s, v[i].w * s);
        *(LAS v2u*)(img + v_off_e(k, n4 >> 3) + (n4 & 7) * 2) = w; }
    LDS_WAIT(); asm volatile("" ::: "memory");
    const int hh = lane >> 5, i16 = lane & 15, q4 = i16 >> 2, p4 = i16 & 3, blk = (lane >> 4) & 1;
#pragma unroll
    for (int s = 0; s < 4; ++s)
#pragma unroll
        for (int mt = 0; mt < 2; ++mt) { const int rlo = 16 * s + 8 * hh + q4, ch = 4 * mt + 2 * blk + (p4 >> 1);
            const s16x4_t lo = vtr_e(img + v_off_e(rlo, ch) + (p4 & 1) * 8), hi = vtr_e(img + v_off_e(rlo + 4, ch) + (p4 & 1) * 8);
            const bf16x8 o = __builtin_shufflevector(lo, hi, 0, 1, 2, 3, 4, 5, 6, 7);
            if constexpr (FP8OUT) { const v4u ow = __builtin_bit_cast(v4u, o); v2u w8;
                w8.x = pk4_fp8(bf_lo(ow.x), bf_hi(ow.x), bf_lo(ow.y), bf_hi(ow.y)); w8.y = pk4_fp8(bf_lo(ow.z), bf_hi(ow.z), bf_lo(ow.w), bf_hi(ow.w));
                *(GAS v2u*)((unsigned char*)WT + (size_t)(n0 + 32 * mt + (lane & 31)) * K + k0 + 16 * s + 8 * hh) = w8; }
            else *(GAS bf16x8*)(WT + (size_t)(n0 + 32 * mt + (lane & 31)) * K + k0 + 16 * s + 8 * hh) = o; }
    LDS_WAIT(); asm volatile("" ::: "memory");
}
__device__ __forceinline__ void p0_transpose_item(const float* W, int K, int N, bf16* WT, int row_off, LAS float* scr, int item, int lane, const float* ksc, int klim, float csc) {
    const int nblk = N / 32, kb = item / nblk, nb = item % nblk, k0 = 64 * kb, n0 = 32 * nb;
#pragma unroll 8
    for (int i = 0; i < 32; ++i) { const int kk = 2 * i + (lane >> 5); const int k = k0 + kk; float s = csc; if (ksc && k < klim) s *= ksc[k];
        scr[kk * 33 + (lane & 31)] = W[(size_t)k * N + n0 + (lane & 31)] * s; }
    LDS_WAIT(); asm volatile("" ::: "memory");
    const int c = lane & 7;
#pragma unroll
    for (int j = 0; j < 4; ++j) { const int n = (lane >> 3) + 8 * j; const LAS float* s = scr + (8 * c) * 33 + n;
        v4u o; o.x = pk2(s[0 * 33], s[1 * 33]); o.y = pk2(s[2 * 33], s[3 * 33]); o.z = pk2(s[4 * 33], s[5 * 33]); o.w = pk2(s[6 * 33], s[7 * 33]);
        *(GAS v4u*)(WT + (size_t)(row_off + n0 + n) * K + k0 + 8 * c) = o; }
    LDS_WAIT(); asm volatile("" ::: "memory");
}
__device__ __forceinline__ int t5_bucket(int rel) {
    const int n = rel < 0 ? -rel : rel; const int off = rel > 0 ? 16 : 0;
    if (n < 8) return off + n;
    int large = 8 + (int)(logf((float)n / 8.0f) / logf(128.0f) * 8.0f);
    if (large > 15) large = 15;
    return off + large;
}
__device__ __forceinline__ void p0_prologue(Frame& F) {
    LAS unsigned char* img = F.lds + RING_OFF + F.wave * 8192;
    const int gw = F.vcu * NWAVES + F.wave, NGW = F.G * NWAVES;
    constexpr int I_IN = (D / 64) * (PW / 64), I_OUT = (D / 64) * (D / 64);
    constexpr int NITEMS = I_IN + I_OUT;
    for (int it = gw; it < NITEMS; it += NGW) {
        int r = it;
        if (r < I_IN) { const int n0 = 64 * (r % (PW / 64)); const float csc = (n0 < C_AK || (n0 >= C_RK && n0 < C_RV)) ? 0.125f : 1.0f;
            p0_transpose64<false>(F.w_in(), D, PW, F.WinT(), img, r, F.lane, F.g_mix(), D, csc); continue; } r -= I_IN;
        p0_transpose64<false>(F.w_out(), D, D, F.WoutT(), img, r, F.lane, F.g_att(), 512, 1.0f);
    }
    const float* x_ = F.x();
    for (int m = gw; m < M; m += NGW) {
        const GAS f32x4* xr = (const GAS f32x4*)(x_ + (size_t)m * D) + F.lane;
        f32x4 v[4]; float s = 0.f;
#pragma unroll
        for (int j = 0; j < 4; ++j) { v[j] = xr[64 * j]; s += (v[j].x * v[j].x + v[j].y * v[j].y) + (v[j].z * v[j].z + v[j].w * v[j].w); }
        const float rstd = 1.f / sqrtf(wave_sum(s) * (1.f / D) + EPS);
        GAS unsigned long long* o8 = (GAS unsigned long long*)(F.XN() + (size_t)m * D) + F.lane;
#pragma unroll
        for (int j = 0; j < 4; ++j) o8[64 * j] = (unsigned long long)pk2(v[j].x * rstd, v[j].y * rstd) | ((unsigned long long)pk2(v[j].z * rstd, v[j].w * rstd) << 32);
    }
    const int gt = F.vcu * 512 + F.tid, NGT = F.G * 512;
    for (int i = gt; i < SEQ * 32; i += NGT) {
        const int pos = i >> 5, fi = i & 31;
        const float inv = powf(10000.0f, -(float)fi / 32.0f);
        const float ang = (float)pos * inv;
        const double a = (double)ang; const double k = rint(a * 0.15915494309189535); const double rr = a - k * 6.283185307179586477;
        F.COS()[i] = (float)cos(rr); F.SIN()[i] = (float)sin(rr);
    }
    const float* rb_ = F.rel_bias();
    for (int i = gt; i < 3 * NH * 132; i += NGT) {
        const int dl = i % 132, h = (i / 132) % NH, br = i / (132 * NH); const int d = br == 0 ? 1 : (br == 1 ? 4 : 16);
        float v = 0.f; if (dl <= 128) v = rb_[t5_bucket((dl - 64) * d) * NH + h];
        F.BIAS()[i] = v;
    }
}

constexpr int CW_WQ = 20480;
__device__ __forceinline__ void expert_convert_queue(Frame& F) {
    constexpr int I_UP = (D / 64) * (FF / 64), I_DN = (FF / 64) * (D / 64), PER_E = 2 * I_UP + I_DN, NITEMS_E = NE * PER_E;
    LAS unsigned char* img = F.lds + RING_OFF + F.wave * 8192;
    volatile LAS int* s_q = (volatile LAS int*)(F.lds + RT_OFF + 1024);
    for (;;) {
        if (F.tid == 0) s_q[0] = (int)__hip_atomic_fetch_add((unsigned*)(F.ctl + CW_WQ), 1u, RLX_AGENT);
        LDS_WAIT(); __syncthreads();
        const int base = s_q[0] * NWAVES;
        __syncthreads();
        if (base >= NITEMS_E) break;
        int r = base + F.wave;
        if (r < NITEMS_E) {
            const int e = r / PER_E; r -= e * PER_E;
            if (r < I_UP) p0_transpose64<true>(F.w1() + (size_t)e * D * FF, D, FF, (bf16*)((unsigned char*)F.W1T() + (size_t)e * FF * D), img, r, F.lane, F.g_ffn(), D, SC_W);
            else if (r < 2 * I_UP) p0_transpose64<true>(F.w3() + (size_t)e * D * FF, D, FF, (bf16*)((unsigned char*)F.W3T() + (size_t)e * FF * D), img, r - I_UP, F.lane, F.g_ffn(), D, SC_W);
            else p0_transpose64<true>(F.w2() + (size_t)e * FF * D, FF, D, (bf16*)((unsigned char*)F.W2T() + (size_t)e * D * FF), img, r - 2 * I_UP, F.lane, nullptr, 0, SC_W);
        }
    }
}
__device__ __forceinline__ void rotary_inplace(Frame& F) {
    const long gt = (long)F.vcu * 512 + F.tid, NGT = (long)F.G * 512;
    const long total = (long)M * 2 * NH * 8;
    for (long u = gt; u < total; u += NGT) {
        const int g4 = (int)(u & 7), h = (int)((u >> 3) & 7), qk = (int)((u >> 6) & 1); const int tok = (int)(u >> 7);
        const int pos = tok & (SEQ - 1);
        bf16* base = F.PROJ() + (size_t)tok * PW + (qk ? C_RK : C_RQ) + h * HD + 4 * g4;
        const v2u a = *(const v2u*)base, b = *(const v2u*)(base + 32);
        const f32x4 c = *(const f32x4*)(F.COS() + pos * 32 + 4 * g4), s = *(const f32x4*)(F.SIN() + pos * 32 + 4 * g4);
        const float t1[4] = {bf_lo(a.x), bf_hi(a.x), bf_lo(a.y), bf_hi(a.y)}, t2[4] = {bf_lo(b.x), bf_hi(b.x), bf_lo(b.y), bf_hi(b.y)};
        float o1[4], o2[4];
#pragma unroll
        for (int j = 0; j < 4; ++j) { o1[j] = t1[j] * c[j] - t2[j] * s[j]; o2[j] = t1[j] * s[j] + t2[j] * c[j]; }
        v2u wa, wb; wa.x = pk2(o1[0], o1[1]); wa.y = pk2(o1[2], o1[3]); wb.x = pk2(o2[0], o2[1]); wb.y = pk2(o2[2], o2[3]);
        *(v2u*)base = wa; *(v2u*)(base + 32) = wb;
    }
}
__device__ __forceinline__ void load_row64(const bf16* p, float (&v)[64]) {
#pragma unroll
    for (int c = 0; c < 8; ++c) { const v4u w = *(const v4u*)(p + 8 * c);
        v[8 * c + 0] = bf_lo(w.x); v[8 * c + 1] = bf_hi(w.x); v[8 * c + 2] = bf_lo(w.y); v[8 * c + 3] = bf_hi(w.y);
        v[8 * c + 4] = bf_lo(w.z); v[8 * c + 5] = bf_hi(w.z); v[8 * c + 6] = bf_lo(w.w); v[8 * c + 7] = bf_hi(w.w); }
}
__device__ __forceinline__ void attn_naive(Frame& F) {
    const long gt = (long)F.vcu * 512 + F.tid, NGT = (long)F.G * 512;
    const long total = 3L * NB * NH * SEQ;
    for (long u = gt; u < total; u += NGT) {
        const int p = (int)(u & (SEQ - 1)), h = (int)((u >> 11) & 7), b = (int)((u >> 14) & 7), br = (int)(u >> 17);
        const int sh = 2 * br, d = 1 << sh, r = p & (d - 1), a = p >> sh, L = SEQ >> sh;
        float q[64]; load_row64(F.PROJ() + (size_t)(b * SEQ + p) * PW + C_AQ + h * HD, q);
        float acc[64];
#pragma unroll
        for (int i = 0; i < 64; ++i) acc[i] = 0.f;
        float mx = -1e30f, l = 0.f;
        const int j0 = a - 64 < 0 ? 0 : a - 64, j1 = a + 64 > L - 1 ? L - 1 : a + 64;
        const float* bias = F.BIAS() + (br * NH + h) * 132 + 64;
        for (int j = j0; j <= j1; ++j) {
            const size_t row = (size_t)(b * SEQ + (j << sh) + r) * PW;
            float kv[64]; load_row64(F.PROJ() + row + C_AK + h * HD, kv);
            float s = 0.f;
#pragma unroll
            for (int i = 0; i < 64; ++i) s += q[i] * kv[i];
            s += bias[j - a];
            const float mn = fmaxf(mx, s), sc = __expf(mx - mn), pp = __expf(s - mn);
            load_row64(F.PROJ() + row + C_AV + h * HD, kv);
            l = l * sc + pp;
#pragma unroll
            for (int i = 0; i < 64; ++i) acc[i] = acc[i] * sc + pp * kv[i];
            mx = mn;
        }
        const float il = 1.f / l;
        bf16* o = F.ATTO() + ((size_t)br * M + (size_t)(b * SEQ + p)) * 512 + h * HD;
#pragma unroll
        for (int c = 0; c < 8; ++c) { v4u w; w.x = pk2(acc[8 * c] * il, acc[8 * c + 1] * il); w.y = pk2(acc[8 * c + 2] * il, acc[8 * c + 3] * il);
            w.z = pk2(acc[8 * c + 4] * il, acc[8 * c + 5] * il); w.w = pk2(acc[8 * c + 6] * il, acc[8 * c + 7] * il); *(v4u*)(o + 8 * c) = w; }
        F.ATTL()[((size_t)br * M + (size_t)(b * SEQ + p)) * NH + h] = mx + __logf(l);
    }
}

namespace mx {
typedef float f32x16 __attribute__((ext_vector_type(16)));
typedef short s16x4 __attribute__((ext_vector_type(4)));
typedef short v4i16_t __attribute__((ext_vector_type(4)));
typedef __bf16 bf16x2_t __attribute__((ext_vector_type(2)));
__device__ __forceinline__ unsigned cvtpk(float lo, float hi) { f32x2 v = {lo, hi}; bf16x2_t b = __builtin_convertvector(v, bf16x2_t); return __builtin_bit_cast(unsigned, b); }
__device__ __forceinline__ s16x4 vtr(const LAS unsigned char* p) { return __builtin_bit_cast(s16x4, __builtin_amdgcn_ds_read_tr16_b64_v4i16((LAS v4i16_t*)p)); }
__device__ __forceinline__ int crow(int r, int hi) { return (r & 3) + 8 * (r >> 2) + 4 * hi; }
__device__ __forceinline__ int k_off(int row, int ch) { return row * 128 + ((ch ^ ((row >> 1) & 7)) << 4); }
__device__ __forceinline__ int v_off(int row, int ch) { return ((row >> 3) * 2 + (ch >> 2)) * 512 + (row & 7) * 64 + (ch & 3) * 16; }
#define MFMA32(a, b, c) __builtin_amdgcn_mfma_f32_32x32x16_bf16((a), (b), (c), 0, 0, 0)
constexpr float LOG2E = 1.4426950408889634f, LN2 = 0.6931471805599453f;

constexpr int AT_K = 0, AT_V = 49152, AT_B = 98304;
constexpr int AT_UNITS = NB * NH * 24;
struct AttnGeo { int b, h, br, sh, L, r0, r1, q0, kbase, nk, nrows; };
__device__ __forceinline__ AttnGeo attn_geo(int u) {
    AttnGeo g; const int sub = u & 7; g.br = (u >> 3) % 3; const int bh = u / 24; g.b = bh >> 3; g.h = bh & 7;
    g.sh = 2 * g.br; g.L = SEQ >> g.sh;
    if (g.br < 2) { g.r0 = (g.br == 0) ? 0 : (sub >> 1); g.r1 = g.r0; g.q0 = (g.br == 0) ? sub * 256 : (sub & 1) * 256; g.kbase = g.q0 - 64 < 0 ? 0 : g.q0 - 64; const int kend = g.q0 + 320 > g.L ? g.L : g.q0 + 320; g.nk = kend - g.kbase; g.nrows = g.nk; }
    else { g.r0 = 2 * sub; g.r1 = g.r0 + 1; g.q0 = 0; g.kbase = 0; g.nk = 128; g.nrows = 256; }
    return g;
}
struct AttnPre { v4u kr[6], vr[6]; bf16x8 qf[4]; float bias0, bias1; };
__device__ __forceinline__ float xhalf_max(float m) { auto rr = __builtin_amdgcn_permlane32_swap(__float_as_uint(m), __float_as_uint(m), false, false); return fmaxf(__uint_as_float(rr[0]), __uint_as_float(rr[1])); }
__device__ __forceinline__ float xhalf_sum(float m) { auto rr = __builtin_amdgcn_permlane32_swap(__float_as_uint(m), __float_as_uint(m), false, false); return __uint_as_float(rr[0]) + __uint_as_float(rr[1]); }
__device__ __forceinline__ void attn_prefetch(Frame& F, int u, AttnPre& P) {
    const AttnGeo g = attn_geo(u);
    const bf16* proj = F.PROJ();
#pragma unroll
    for (int it = 0; it < 6; ++it) { const int c = F.tid + 512 * it, ch = c & 7; int row = c >> 3; row = row < g.nrows ? row : g.nrows - 1;
        const int seg = (g.br == 2) ? (row >> 7) : 0, li = row - seg * g.nk; const int tok = g.b * SEQ + ((g.kbase + li) << g.sh) + (seg ? g.r1 : g.r0);
        const bf16* p = proj + (size_t)tok * PW + g.h * HD + ch * 8; P.kr[it] = *(const v4u*)(p + C_AK); P.vr[it] = *(const v4u*)(p + C_AV); }
    const int w = F.wave, qc = F.lane & 31, hh = F.lane >> 5;
    const int seg = (g.br == 2) ? (w >> 2) : 0, qs = (g.br == 2) ? 32 * (w & 3) : g.q0 + 32 * w;
    const int tq = g.b * SEQ + ((qs + qc) << g.sh) + (seg ? g.r1 : g.r0);
    const bf16* qp = proj + (size_t)tq * PW + C_AQ + g.h * HD + 8 * hh;
#pragma unroll
    for (int s = 0; s < 4; ++s) P.qf[s] = *(const bf16x8*)(qp + 16 * s);
    { const float* bt = F.BIAS() + (g.br * NH + g.h) * 132;
      const int e0 = F.tid, e1 = (F.tid + 512) < 768 ? F.tid + 512 : 767;
      int d0 = (e0 % 192) + (e0 / 192) - 32, d1 = (e1 % 192) + (e1 / 192) - 32;
      d0 = d0 < 0 ? 0 : (d0 > 128 ? 128 : d0); d1 = d1 < 0 ? 0 : (d1 > 128 ? 128 : d1);
      P.bias0 = bt[d0]; P.bias1 = bt[d1]; }
}
template <int MODE> __device__ __forceinline__ void attn_unit(Frame& F, int u, int un, AttnPre& P) {
    const AttnGeo g = attn_geo(u);
    const int b = g.b, h = g.h, br = g.br, sh = g.sh, L = g.L, kbase = g.kbase, nk = g.nk, nrows = g.nrows;
    LAS unsigned char* lds = F.lds;
    __syncthreads();
    if (MODE != 2)
#pragma unroll
    for (int it = 0; it < 6; ++it) { const int c = F.tid + 512 * it, row = c >> 3, ch = c & 7;
        if (row < nrows) { *(LAS v4u*)(lds + AT_K + k_off(row, ch)) = P.kr[it]; *(LAS v4u*)(lds + AT_V + v_off(row, ch)) = P.vr[it]; } }
    { const int e0 = F.tid, e1 = F.tid + 512; const int d0 = (e0 % 192) + (e0 / 192) - 32, d1 = (e1 % 192) + (e1 / 192) - 32;
      ((LAS float*)(lds + AT_B))[e0] = (d0 >= 0 && d0 <= 128) ? P.bias0 * LOG2E : 0.f;
      if (e1 < 768) ((LAS float*)(lds + AT_B))[e1] = (d1 >= 0 && d1 <= 128) ? P.bias1 * LOG2E : 0.f; }
    bf16x8 qf[4];
#pragma unroll
    for (int s = 0; s < 4; ++s) qf[s] = P.qf[s];
    LDS_WAIT(); __syncthreads();
    if (MODE != 2) attn_prefetch(F, un, P);
    if (MODE == 1) return;
    const int w = F.wave, lane = F.lane, qc = lane & 31, hh = lane >> 5;
    const int seg = (br == 2) ? (w >> 2) : 0, qs = (br == 2) ? 32 * (w & 3) : g.q0 + 32 * w;
    const int tq = b * SEQ + ((qs + qc) << sh) + (seg ? g.r1 : g.r0);
    const int i16 = lane & 15, q4 = i16 >> 2, p4 = i16 & 3, blk = (lane >> 4) & 1;
    float mrun = -1e30f, lrun = 0.f;
    f32x16 O[2];
#pragma unroll
    for (int i = 0; i < 16; ++i) { O[0][i] = 0.f; O[1][i] = 0.f; }
    const int bsh = (-qc) & 3;
    const LAS f32x4* bl4 = (const LAS f32x4*)(lds + AT_B) + bsh * 48;
#pragma unroll
    for (int tt = 0; tt < 5; ++tt) {
        const int t = (tt == 0) ? 2 : (tt == 1 ? 1 : (tt == 2 ? 3 : (tt == 3 ? 0 : 4)));
        const int kp = qs + 32 * (t - 2); const bool valid = (kp >= 0) && (kp < L);
        const int R0 = seg * nk + ((valid ? kp : qs) - kbase);
        f32x16 S;
#pragma unroll
        for (int i = 0; i < 16; ++i) S[i] = 0.f;
        bf16x8 kf[4];
#pragma unroll
        for (int s = 0; s < 4; ++s) kf[s] = *(const LAS bf16x8*)(lds + AT_K + k_off(R0 + qc, 2 * s + hh));
        f32x4 bv[4];
        { const int ab = (96 + 32 * (t - 2) + 4 * hh - qc - bsh) >> 2;
#pragma unroll
          for (int gq = 0; gq < 4; ++gq) bv[gq] = bl4[ab + 2 * gq]; }
#pragma unroll
        for (int s = 0; s < 4; ++s) S = MFMA32(kf[s], qf[s], S);
        float tmax = -1e30f;
#pragma unroll
        for (int i = 0; i < 16; ++i) { const int kr = crow(i, hh); float v = S[i] * LOG2E + bv[i >> 2][i & 3];
            if (t == 0 && kr < qc) v = -1e30f; if (t == 4 && kr > qc) v = -1e30f; if (t != 2 && !valid) v = -1e30f; S[i] = v; tmax = fmaxf(tmax, v); }
        tmax = xhalf_max(tmax);
        if (tt == 0) mrun = tmax;
        else if (__any(tmax > mrun + 8.0f)) {
            const float mnew = fmaxf(mrun, tmax), alpha = __builtin_amdgcn_exp2f(mrun - mnew); mrun = mnew; lrun *= alpha;
#pragma unroll
            for (int i = 0; i < 16; ++i) { O[0][i] *= alpha; O[1][i] *= alpha; } }
        float ls = 0.f;
#pragma unroll
        for (int i = 0; i < 16; ++i) { const float p = __builtin_amdgcn_exp2f(S[i] - mrun); S[i] = p; ls += p; }
        lrun += ls;
#pragma unroll
        for (int s2 = 0; s2 < 2; ++s2) {
            v4u pw; pw.x = cvtpk(S[8 * s2 + 0], S[8 * s2 + 1]); pw.y = cvtpk(S[8 * s2 + 2], S[8 * s2 + 3]); pw.z = cvtpk(S[8 * s2 + 4], S[8 * s2 + 5]); pw.w = cvtpk(S[8 * s2 + 6], S[8 * s2 + 7]);
            const bf16x8 pb = __builtin_bit_cast(bf16x8, pw);
            const int rlo = R0 + 16 * s2 + 4 * hh + q4;
#pragma unroll
            for (int dt = 0; dt < 2; ++dt) {
                const int ch = 4 * dt + 2 * blk + (p4 >> 1);
                const s16x4 lo = vtr(lds + AT_V + v_off(rlo, ch) + (p4 & 1) * 8), hi = vtr(lds + AT_V + v_off(rlo + 8, ch) + (p4 & 1) * 8);
                O[dt] = MFMA32(__builtin_shufflevector(lo, hi, 0, 1, 2, 3, 4, 5, 6, 7), pb, O[dt]);
            }
        }
    }
    const float l = xhalf_sum(lrun);
    const float il = 1.f / l;
    bf16* op = (MODE ? (bf16*)(F.ws + WS_MIX) : F.ATTO()) + ((size_t)(MODE ? 0 : br) * M + tq) * 512 + h * HD + 4 * hh;
#pragma unroll
    for (int dt = 0; dt < 2; ++dt)
#pragma unroll
        for (int gq = 0; gq < 4; ++gq) { v2u wv; wv.x = cvtpk(O[dt][4 * gq] * il, O[dt][4 * gq + 1] * il); wv.y = cvtpk(O[dt][4 * gq + 2] * il, O[dt][4 * gq + 3] * il); *(v2u*)(op + 32 * dt + 8 * gq) = wv; }
    if (hh == 0) (MODE ? (float*)(F.ws + WS_MIX + 24 * MiB) : F.ATTL())[((size_t)(MODE ? 0 : br) * M + tq) * NH + h] = (mrun + __builtin_amdgcn_logf(l)) * LN2;
}
template <int MODE> __device__ __forceinline__ void attn_phase(Frame& F) {
    if (F.vcu < AT_UNITS) {
        AttnPre P;
        attn_prefetch(F, F.vcu, P);
        for (int u = F.vcu; u < AT_UNITS; u += F.G) { const int un = (u + F.G < AT_UNITS) ? u + F.G : u; attn_unit<MODE>(F, u, un, P); }
    }
    __syncthreads();
}
__device__ __forceinline__ void load_rot8(const Frame& F, const bf16* p, int pos, int ch, float (&o1)[8], float (&o2)[8]) {
    const v4u a = *(const v4u*)(p + 8 * ch), b = *(const v4u*)(p + 32 + 8 * ch);
    const f32x4 c0 = *(const f32x4*)(F.COS() + pos * 32 + 8 * ch), c1 = *(const f32x4*)(F.COS() + pos * 32 + 8 * ch + 4);
    const f32x4 s0 = *(const f32x4*)(F.SIN() + pos * 32 + 8 * ch), s1 = *(const f32x4*)(F.SIN() + pos * 32 + 8 * ch + 4);
    const float t1[8] = {bf_lo(a.x), bf_hi(a.x), bf_lo(a.y), bf_hi(a.y), bf_lo(a.z), bf_hi(a.z), bf_lo(a.w), bf_hi(a.w)};
    const float t2[8] = {bf_lo(b.x), bf_hi(b.x), bf_lo(b.y), bf_hi(b.y), bf_lo(b.z), bf_hi(b.z), bf_lo(b.w), bf_hi(b.w)};
    const float cs[8] = {c0.x, c0.y, c0.z, c0.w, c1.x, c1.y, c1.z, c1.w}, sn[8] = {s0.x, s0.y, s0.z, s0.w, s1.x, s1.y, s1.z, s1.w};
#pragma unroll
    for (int j = 0; j < 8; ++j) { o1[j] = t1[j] * cs[j] - t2[j] * sn[j]; o2[j] = t1[j] * sn[j] + t2[j] * cs[j]; }
}
__device__ __forceinline__ v4u pack8(const float (&o)[8], float s) { v4u w; w.x = cvtpk(o[0] * s, o[1] * s); w.y = cvtpk(o[2] * s, o[3] * s); w.z = cvtpk(o[4] * s, o[5] * s); w.w = cvtpk(o[6] * s, o[7] * s); return w; }
constexpr int R1_UNITS = NB * NH * NCH;
__device__ __forceinline__ void ret_kv_unit(Frame& F, int u) {
    const int c = u & (NCH - 1), bh = u >> 4, b = bh >> 3, h = bh & 7;
    const float lgf = -__expf(F.dec_f()[h]) * LOG2E, lgb = -__expf(F.dec_b()[h]) * LOG2E;
    LAS unsigned char* lds = F.lds;
    __syncthreads();
    { const int row = F.tid >> 2, ch = F.tid & 3; const int pos = c * RC + row, tok = b * SEQ + pos;
      const bf16* p = F.PROJ() + (size_t)tok * PW + h * HD;
      float o1[8], o2[8]; load_rot8(F, p + C_RK, pos, ch, o1, o2);
      const v4u va = *(const v4u*)(p + C_RV + 8 * ch), vb = *(const v4u*)(p + C_RV + 32 + 8 * ch);
      const float df = __builtin_amdgcn_exp2f(lgf * (float)(RC - 1 - row)), db = __builtin_amdgcn_exp2f(lgb * (float)row);
      *(LAS v4u*)(lds + 0 + v_off(row, ch)) = pack8(o1, df); *(LAS v4u*)(lds + 0 + v_off(row, ch + 4)) = pack8(o2, df);
      *(LAS v4u*)(lds + 16384 + v_off(row, ch)) = pack8(o1, db); *(LAS v4u*)(lds + 16384 + v_off(row, ch + 4)) = pack8(o2, db);
      *(LAS v4u*)(lds + 32768 + v_off(row, ch)) = va; *(LAS v4u*)(lds + 32768 + v_off(row, ch + 4)) = vb; }
    LDS_WAIT(); __syncthreads();
    const int w = F.wave, lane = F.lane, hh = lane >> 5, dir = w >> 2, mt = (w >> 1) & 1, nt = w & 1;
    const int i16 = lane & 15, q4 = i16 >> 2, p4 = i16 & 3, blk = (lane >> 4) & 1;
    f32x16 acc;
#pragma unroll
    for (int i = 0; i < 16; ++i) acc[i] = 0.f;
    const LAS unsigned char* kim = lds + dir * 16384; const LAS unsigned char* vim = lds + 32768;
#pragma unroll
    for (int s = 0; s < 8; ++s) {
        const int rlo = 16 * s + 8 * hh + q4;
        const int cha = 4 * mt + 2 * blk + (p4 >> 1), chb = 4 * nt + 2 * blk + (p4 >> 1);
        const s16x4 alo = vtr(kim + v_off(rlo, cha) + (p4 & 1) * 8), ahi = vtr(kim + v_off(rlo + 4, cha) + (p4 & 1) * 8);
        const s16x4 blo = vtr(vim + v_off(rlo, chb) + (p4 & 1) * 8), bhi = vtr(vim + v_off(rlo + 4, chb) + (p4 & 1) * 8);
        acc = MFMA32(__builtin_shufflevector(alo, ahi, 0, 1, 2, 3, 4, 5, 6, 7), __builtin_shufflevector(blo, bhi, 0, 1, 2, 3, 4, 5, 6, 7), acc);
    }
    float* o = F.KV() + ((size_t)(u * 2 + dir)) * 4096 + (32 * mt) * 64 + 32 * nt + (lane & 31);
#pragma unroll
    for (int i = 0; i < 16; ++i) o[crow(i, hh) * 64] = acc[i];
}
constexpr int R2_UNITS = NB * NH * (NCH / 2);
constexpr int R2_CH = 49152, R2_K = 0, R2_V = 16384, R2_SF = 32768, R2_SB = 40960;
__device__ __forceinline__ void ret_out_unit(Frame& F, int u) {
    const int cp = u & 7, bh = u >> 3, b = bh >> 3, h = bh & 7, c0 = 2 * cp, c1 = c0 + 1;
    const float lgf = -__expf(F.dec_f()[h]) * LOG2E, lgb = -__expf(F.dec_b()[h]) * LOG2E;
    LAS unsigned char* lds = F.lds;
    __syncthreads();
#pragma unroll
    for (int j = 0; j < 2; ++j) { const int row = F.tid >> 2, ch = F.tid & 3; const int pos = (c0 + j) * RC + row, tok = b * SEQ + pos;
        const bf16* p = F.PROJ() + (size_t)tok * PW + h * HD;
        float o1[8], o2[8]; load_rot8(F, p + C_RK, pos, ch, o1, o2);
        const v4u va = *(const v4u*)(p + C_RV + 8 * ch), vb = *(const v4u*)(p + C_RV + 32 + 8 * ch);
        LAS unsigned char* cb = lds + j * R2_CH;
        *(LAS v4u*)(cb + R2_K + k_off(row, ch)) = pack8(o1, 1.f); *(LAS v4u*)(cb + R2_K + k_off(row, ch + 4)) = pack8(o2, 1.f);
        *(LAS v4u*)(cb + R2_V + v_off(row, ch)) = va; *(LAS v4u*)(cb + R2_V + v_off(row, ch + 4)) = vb; }
    { const int dk = F.tid >> 3, dv8 = (F.tid & 7) * 8;
      const float* kvb = F.KV() + (size_t)(bh * NCH) * 2 * 4096 + dk * 64 + dv8;
      float sf[8], sb[8];
#pragma unroll
      for (int e = 0; e < 8; ++e) { sf[e] = 0.f; sb[e] = 0.f; }
#pragma unroll 8
      for (int cc = 0; cc < c0; ++cc) { const float wgt = __builtin_amdgcn_exp2f(lgf * (float)(RC * (c0 - 1 - cc))); const float* q = kvb + (size_t)(cc * 2 + 0) * 4096;
          const f32x4 a = *(const f32x4*)q, bq = *(const f32x4*)(q + 4);
          sf[0] += wgt * a.x; sf[1] += wgt * a.y; sf[2] += wgt * a.z; sf[3] += wgt * a.w; sf[4] += wgt * bq.x; sf[5] += wgt * bq.y; sf[6] += wgt * bq.z; sf[7] += wgt * bq.w; }
#pragma unroll 8
      for (int cc = c1 + 1; cc < NCH; ++cc) { const float wgt = __builtin_amdgcn_exp2f(lgb * (float)(RC * (cc - c1 - 1))); const float* q = kvb + (size_t)(cc * 2 + 1) * 4096;
          const f32x4 a = *(const f32x4*)q, bq = *(const f32x4*)(q + 4);
          sb[0] += wgt * a.x; sb[1] += wgt * a.y; sb[2] += wgt * a.z; sb[3] += wgt * a.w; sb[4] += wgt * bq.x; sb[5] += wgt * bq.y; sb[6] += wgt * bq.z; sb[7] += wgt * bq.w; }
      float sf1[8], sb0[8];
      { const float gf = __builtin_amdgcn_exp2f(lgf * (float)RC), gb = __builtin_amdgcn_exp2f(lgb * (float)RC);
        const float* qf_ = kvb + (size_t)(c0 * 2 + 0) * 4096; const float* qb_ = kvb + (size_t)(c1 * 2 + 1) * 4096;
        const f32x4 a = *(const f32x4*)qf_, a2 = *(const f32x4*)(qf_ + 4), c = *(const f32x4*)qb_, c2 = *(const f32x4*)(qb_ + 4);
        const float kf[8] = {a.x, a.y, a.z, a.w, a2.x, a2.y, a2.z, a2.w}, kb[8] = {c.x, c.y, c.z, c.w, c2.x, c2.y, c2.z, c2.w};
#pragma unroll
        for (int e = 0; e < 8; ++e) { sf1[e] = gf * sf[e] + kf[e]; sb0[e] = gb * sb[e] + kb[e]; } }
      const int cho = (dk >> 3), bo = (dk & 7) * 2;
#pragma unroll
      for (int e = 0; e < 8; ++e) { const int dv = dv8 + e; const int off = k_off(dv, cho) + bo;
          *(LAS unsigned short*)(lds + 0 * R2_CH + R2_SF + off) = (unsigned short)f2bf(sf[e]);  *(LAS unsigned short*)(lds + 0 * R2_CH + R2_SB + off) = (unsigned short)f2bf(sb0[e]);
          *(LAS unsigned short*)(lds + 1 * R2_CH + R2_SF + off) = (unsigned short)f2bf(sf1[e]); *(LAS unsigned short*)(lds + 1 * R2_CH + R2_SB + off) = (unsigned short)f2bf(sb[e]); }
    }
    const int w = F.wave, lane = F.lane, qc = lane & 31, hh = lane >> 5, j = w >> 2, qt = w & 3;
    const int n = 32 * qt + qc, pos = (c0 + j) * RC + n, tok = b * SEQ + pos;
    bf16x8 qf[4];
    { const bf16* qp = F.PROJ() + (size_t)tok * PW + C_RQ + h * HD + 8 * hh;
      v4u raw[4];
#pragma unroll
      for (int s = 0; s < 4; ++s) raw[s] = *(const v4u*)(qp + 16 * s);
#pragma unroll
      for (int s = 0; s < 2; ++s) {
          const float* cp_ = F.COS() + pos * 32 + 16 * s + 8 * hh; const float* sp_ = F.SIN() + pos * 32 + 16 * s + 8 * hh;
          const f32x4 cA = *(const f32x4*)cp_, cB = *(const f32x4*)(cp_ + 4), sA = *(const f32x4*)sp_, sB = *(const f32x4*)(sp_ + 4);
          const float cs[8] = {cA.x, cA.y, cA.z, cA.w, cB.x, cB.y, cB.z, cB.w}, sn[8] = {sA.x, sA.y, sA.z, sA.w, sB.x, sB.y, sB.z, sB.w};
          const v4u a = raw[s], bq = raw[s + 2];
          const float t1[8] = {bf_lo(a.x), bf_hi(a.x), bf_lo(a.y), bf_hi(a.y), bf_lo(a.z), bf_hi(a.z), bf_lo(a.w), bf_hi(a.w)};
          const float t2[8] = {bf_lo(bq.x), bf_hi(bq.x), bf_lo(bq.y), bf_hi(bq.y), bf_lo(bq.z), bf_hi(bq.z), bf_lo(bq.w), bf_hi(bq.w)};
          float o1[8], o2[8];
#pragma unroll
          for (int e = 0; e < 8; ++e) { o1[e] = t1[e] * cs[e] - t2[e] * sn[e]; o2[e] = t1[e] * sn[e] + t2[e] * cs[e]; }
          qf[s] = __builtin_bit_cast(bf16x8, pack8(o1, 1.f)); qf[s + 2] = __builtin_bit_cast(bf16x8, pack8(o2, 1.f)); } }
    LDS_WAIT(); __syncthreads();
    const LAS unsigned char* cb = lds + j * R2_CH;
    f32x16 Y[2];
#pragma unroll
    for (int i = 0; i < 16; ++i) { Y[0][i] = 0.f; Y[1][i] = 0.f; }
    const int i16 = lane & 15, q4 = i16 >> 2, p4 = i16 & 3, blk = (lane >> 4) & 1;
#pragma unroll
    for (int t = 0; t < 4; ++t) {
        f32x16 S;
#pragma unroll
        for (int i = 0; i < 16; ++i) S[i] = 0.f;
#pragma unroll
        for (int s = 0; s < 4; ++s) { const bf16x8 a = *(const LAS bf16x8*)(cb + R2_K + k_off(32 * t + qc, 2 * s + hh)); S = MFMA32(a, qf[s], S); }
#pragma unroll
        for (int i = 0; i < 16; ++i) { const int m = 32 * t + crow(i, hh); const int dd = n - m;
            const float dec = __builtin_amdgcn_exp2f((dd >= 0 ? lgf : -lgb) * (float)dd); S[i] *= dec; }
#pragma unroll
        for (int s2 = 0; s2 < 2; ++s2) {
            v4u pw; pw.x = cvtpk(S[8 * s2 + 0], S[8 * s2 + 1]); pw.y = cvtpk(S[8 * s2 + 2], S[8 * s2 + 3]); pw.z = cvtpk(S[8 * s2 + 4], S[8 * s2 + 5]); pw.w = cvtpk(S[8 * s2 + 6], S[8 * s2 + 7]);
            const bf16x8 pb = __builtin_bit_cast(bf16x8, pw);
            const int rlo = 32 * t + 16 * s2 + 4 * hh + q4;
#pragma unroll
            for (int dt = 0; dt < 2; ++dt) { const int ch = 4 * dt + 2 * blk + (p4 >> 1);
                const s16x4 lo = vtr(cb + R2_V + v_off(rlo, ch) + (p4 & 1) * 8), hi = vtr(cb + R2_V + v_off(rlo + 8, ch) + (p4 & 1) * 8);
                Y[dt] = MFMA32(__builtin_shufflevector(lo, hi, 0, 1, 2, 3, 4, 5, 6, 7), pb, Y[dt]); }
        }
        __builtin_amdgcn_sched_barrier(0);
    }
    const float qdf = __builtin_amdgcn_exp2f(lgf * (float)(n + 1)), qdb = __builtin_amdgcn_exp2f(lgb * (float)(RC - n));
#pragma unroll
    for (int dir = 0; dir < 2; ++dir) {
        const float qd = dir ? qdb : qdf;
#pragma unroll
        for (int dt = 0; dt < 2; ++dt) { f32x16 T;
#pragma unroll
            for (int i = 0; i < 16; ++i) T[i] = 0.f;
#pragma unroll
            for (int s = 0; s < 4; ++s) { const bf16x8 a = *(const LAS bf16x8*)(cb + (dir ? R2_SB : R2_SF) + k_off(32 * dt + qc, 2 * s + hh)); T = MFMA32(a, qf[s], T); }
#pragma unroll
            for (int i = 0; i < 16; ++i) Y[dt][i] += qd * T[i]; }
    }
    float ss = 0.f;
#pragma unroll
    for (int i = 0; i < 16; ++i) ss += Y[0][i] * Y[0][i] + Y[1][i] * Y[1][i];
    ss += __shfl_xor(ss, 32);
    const float rs = 1.f / sqrtf(ss * (1.f / 64.f) + EPS);
    const bf16* gp = F.PROJ() + (size_t)tok * PW + C_RG + h * HD + 4 * hh;
    bf16* op = F.MIX() + (size_t)tok * D + 512 + h * HD + 4 * hh;
    v2u gwv[2][4];
#pragma unroll
    for (int dt = 0; dt < 2; ++dt)
#pragma unroll
        for (int g = 0; g < 4; ++g) gwv[dt][g] = *(const v2u*)(gp + 32 * dt + 8 * g);
#pragma unroll
    for (int dt = 0; dt < 2; ++dt)
#pragma unroll
        for (int g = 0; g < 4; ++g) { const v2u gw = gwv[dt][g];
            const float gg[4] = {bf_lo(gw.x), bf_hi(gw.x), bf_lo(gw.y), bf_hi(gw.y)}; float y[4];
#pragma unroll
            for (int e = 0; e < 4; ++e) y[e] = Y[dt][4 * g + e] * rs * (gg[e] / (1.f + __expf(-gg[e])));
            v2u wv; wv.x = cvtpk(y[0], y[1]); wv.y = cvtpk(y[2], y[3]); *(v2u*)(op + 32 * dt + 8 * g) = wv; }
}
__device__ __forceinline__ void ret_kv_phase(Frame& F) { for (int u = F.vcu; u < R1_UNITS; u += F.G) ret_kv_unit(F, u); __syncthreads(); }
__device__ __forceinline__ void ret_out_phase(Frame& F) { for (int u = F.vcu; u < R2_UNITS; u += F.G) ret_out_unit(F, u); __syncthreads(); }
}

__device__ __forceinline__ void ret_naive(Frame& F) {
    const long gt = (long)F.vcu * 512 + F.tid, NGT = (long)F.G * 512;
    const long total = (long)NB * NH * SEQ;
    for (long u = gt; u < total; u += NGT) {
        const int n = (int)(u & (SEQ - 1)), h = (int)((u >> 11) & 7), b = (int)(u >> 14);
        const float lgf = -__expf(F.dec_f()[h]) * 1.4426950408889634f, lgb = -__expf(F.dec_b()[h]) * 1.4426950408889634f;
        float q[64]; load_row64(F.PROJ() + (size_t)(b * SEQ + n) * PW + C_RQ + h * HD, q);
        float acc[64];
#pragma unroll
        for (int i = 0; i < 64; ++i) acc[i] = 0.f;
        for (int m = 0; m < SEQ; ++m) {
            const size_t row = (size_t)(b * SEQ + m) * PW;
            float kv[64]; load_row64(F.PROJ() + row + C_RK + h * HD, kv);
            float s = 0.f;
#pragma unroll
            for (int i = 0; i < 64; ++i) s += q[i] * kv[i];
            const float dec = (m <= n) ? exp2f(lgf * (float)(n - m)) : exp2f(lgb * (float)(m - n));
            s *= dec;
            load_row64(F.PROJ() + row + C_RV + h * HD, kv);
#pragma unroll
            for (int i = 0; i < 64; ++i) acc[i] += s * kv[i];
        }
        float ss = 0.f;
#pragma unroll
        for (int i = 0; i < 64; ++i) ss += acc[i] * acc[i];
        const float rs = 1.f / sqrtf(ss * (1.f / 64.f) + EPS);
        float g[64]; load_row64(F.PROJ() + (size_t)(b * SEQ + n) * PW + C_RG + h * HD, g);
        bf16* o = F.MIX() + (size_t)(b * SEQ + n) * D + 512 + h * HD;
        float y[64];
#pragma unroll
        for (int i = 0; i < 64; ++i) { const float gg = g[i]; y[i] = acc[i] * rs * (gg / (1.f + __expf(-gg))); }
#pragma unroll
        for (int c = 0; c < 8; ++c) { v4u w; w.x = pk2(y[8 * c], y[8 * c + 1]); w.y = pk2(y[8 * c + 2], y[8 * c + 3]); w.z = pk2(y[8 * c + 4], y[8 * c + 5]); w.w = pk2(y[8 * c + 6], y[8 * c + 7]); *(v4u*)(o + 8 * c) = w; }
    }
}
__device__ __forceinline__ void attn_combine(Frame& F) {
    const int gw = F.vcu * NWAVES + F.wave, NGW = F.G * NWAVES;
    for (int tok = gw; tok < M; tok += NGW) {
        const int h = F.lane >> 3;
        const float l0 = F.ATTL()[((size_t)0 * M + tok) * NH + h], l1 = F.ATTL()[((size_t)1 * M + tok) * NH + h], l2 = F.ATTL()[((size_t)2 * M + tok) * NH + h];
        const float mx = fmaxf(l0, fmaxf(l1, l2)); const float e0 = __expf(l0 - mx), e1 = __expf(l1 - mx), e2 = __expf(l2 - mx); const float inv = 1.f / (e0 + e1 + e2);
        const float w0 = e0 * inv, w1 = e1 * inv, w2 = e2 * inv;
        const v4u a = *(const v4u*)(F.ATTO() + ((size_t)0 * M + tok) * 512 + 8 * F.lane), b = *(const v4u*)(F.ATTO() + ((size_t)1 * M + tok) * 512 + 8 * F.lane), c = *(const v4u*)(F.ATTO() + ((size_t)2 * M + tok) * 512 + 8 * F.lane);
        float o[8];
        o[0] = w0 * bf_lo(a.x) + w1 * bf_lo(b.x) + w2 * bf_lo(c.x); o[1] = w0 * bf_hi(a.x) + w1 * bf_hi(b.x) + w2 * bf_hi(c.x);
        o[2] = w0 * bf_lo(a.y) + w1 * bf_lo(b.y) + w2 * bf_lo(c.y); o[3] = w0 * bf_hi(a.y) + w1 * bf_hi(b.y) + w2 * bf_hi(c.y);
        o[4] = w0 * bf_lo(a.z) + w1 * bf_lo(b.z) + w2 * bf_lo(c.z); o[5] = w0 * bf_hi(a.z) + w1 * bf_hi(b.z) + w2 * bf_hi(c.z);
        o[6] = w0 * bf_lo(a.w) + w1 * bf_lo(b.w) + w2 * bf_lo(c.w); o[7] = w0 * bf_hi(a.w) + w1 * bf_hi(b.w) + w2 * bf_hi(c.w);
        float ss = 0.f;
#pragma unroll
        for (int i = 0; i < 8; ++i) ss += o[i] * o[i];
        const float rs = 1.f / sqrtf(wave_sum(ss) * (1.f / 512.f) + EPS);
        v4u w; w.x = pk2(o[0] * rs, o[1] * rs); w.y = pk2(o[2] * rs, o[3] * rs); w.z = pk2(o[4] * rs, o[5] * rs); w.w = pk2(o[6] * rs, o[7] * rs);
        *(v4u*)(F.MIX() + (size_t)tok * D + 8 * F.lane) = w;
    }
}
template <bool DRY> __device__ __forceinline__ void router(Frame& F) {
    LAS int* s_cls = (LAS int*)(F.lds + RT_OFF); LAS float* s_glo = (LAS float*)(F.lds + RT_OFF + 256); LAS float* s_ghi = (LAS float*)(F.lds + RT_OFF + 512);
    LAS int* s_base = (LAS int*)(F.lds + RT_OFF + 768);
    LAS f32x4* wl = (LAS f32x4*)(F.lds + RING_OFF);
    { const float* rgw_ = F.rgw(); const float* rew_ = F.rew(); const float* gf_ = F.g_ffn();
    for (int i = F.tid; i < 5 * D; i += NWAVES * 64) { const int m = i >> 10, k = i & (D - 1);
        const f32x4 w = (m == 0) ? *(const f32x4*)(rgw_ + (size_t)k * 4) : *(const f32x4*)(rew_ + ((size_t)(m - 1) * D + k) * 4);
        wl[i] = w * gf_[k]; } }
    LDS_WAIT(); __syncthreads();
    const float* h1 = F.out; const float* rgb_ = F.rgb(); const float* reb_ = F.reb();
    for (int blk = F.vcu; blk < M / 64; blk += F.G) {
#pragma unroll 1
        for (int tb = 0; tb < 2; ++tb) {
            f32x4 v[4][4]; float ssq[4];
#pragma unroll
            for (int t = 0; t < 4; ++t) { const int tok = blk * 64 + F.wave * 8 + tb * 4 + t; const GAS f32x4* hr = (const GAS f32x4*)(h1 + (size_t)tok * D) + F.lane;
#pragma unroll
                for (int j = 0; j < 4; ++j) v[t][j] = hr[64 * j]; }
#pragma unroll
            for (int t = 0; t < 4; ++t) { float s = 0.f;
#pragma unroll
                for (int j = 0; j < 4; ++j) s += (v[t][j].x * v[t][j].x + v[t][j].y * v[t][j].y) + (v[t][j].z * v[t][j].z + v[t][j].w * v[t][j].w);
                ssq[t] = s; }
#pragma unroll
            for (int o = 1; o < 64; o <<= 1) {
#pragma unroll
                for (int t = 0; t < 4; ++t) ssq[t] += __shfl_xor(ssq[t], o); }
            float gl[4][4];
#pragma unroll
            for (int t = 0; t < 4; ++t) { const int tok = blk * 64 + F.wave * 8 + tb * 4 + t; const float rstd = 1.f / sqrtf(ssq[t] * (1.f / D) + EPS);
                GAS unsigned* o4 = (GAS unsigned*)((DRY ? (unsigned char*)(F.ws + WS_PROJ + 48 * MiB) : (unsigned char*)F.XN()) + (size_t)tok * D) + F.lane;
#pragma unroll
                for (int j = 0; j < 4; ++j) { v[t][j] = v[t][j] * rstd; const f32x4 s8 = v[t][j] * SC_HN; o4[64 * j] = pk4_fp8(s8.x, s8.y, s8.z, s8.w); }
#pragma unroll
                for (int e = 0; e < 4; ++e) gl[t][e] = 0.f; }
#pragma unroll
            for (int j = 0; j < 4; ++j)
#pragma unroll
                for (int e = 0; e < 4; ++e) { const f32x4 w = wl[4 * F.lane + 256 * j + e];
#pragma unroll
                    for (int t = 0; t < 4; ++t) { gl[t][0] += v[t][j][e] * w.x; gl[t][1] += v[t][j][e] * w.y; gl[t][2] += v[t][j][e] * w.z; gl[t][3] += v[t][j][e] * w.w; } }
#pragma unroll
            for (int o = 1; o < 64; o <<= 1) {
#pragma unroll
                for (int t = 0; t < 4; ++t)
#pragma unroll
                    for (int e = 0; e < 4; ++e) gl[t][e] += __shfl_xor(gl[t][e], o); }
            int gsel[4]; float pgv[4]; float el[4][4];
#pragma unroll
            for (int t = 0; t < 4; ++t) {
#pragma unroll
                for (int e = 0; e < 4; ++e) gl[t][e] += rgb_[e];
                int g = 0; float gm = gl[t][0];
#pragma unroll
                for (int e = 1; e < 4; ++e) if (gl[t][e] > gm) { gm = gl[t][e]; g = e; }
                gsel[t] = g; pgv[t] = 1.f / (__expf(gl[t][0] - gm) + __expf(gl[t][1] - gm) + __expf(gl[t][2] - gm) + __expf(gl[t][3] - gm));
#pragma unroll
                for (int e = 0; e < 4; ++e) el[t][e] = 0.f; }
#pragma unroll
            for (int t = 0; t < 4; ++t) { const LAS f32x4* we = wl + (1 + gsel[t]) * D;
#pragma unroll
                for (int j = 0; j < 4; ++j)
#pragma unroll
                    for (int e = 0; e < 4; ++e) { const f32x4 w = we[4 * F.lane + 256 * j + e];
                        el[t][0] += v[t][j][e] * w.x; el[t][1] += v[t][j][e] * w.y; el[t][2] += v[t][j][e] * w.z; el[t][3] += v[t][j][e] * w.w; } }
#pragma unroll
            for (int o = 1; o < 64; o <<= 1) {
#pragma unroll
                for (int t = 0; t < 4; ++t)
#pragma unroll
                    for (int e = 0; e < 4; ++e) el[t][e] += __shfl_xor(el[t][e], o); }
#pragma unroll
            for (int t = 0; t < 4; ++t) { const int g = gsel[t], tl = F.wave * 8 + tb * 4 + t;
#pragma unroll
                for (int e = 0; e < 4; ++e) el[t][e] += reb_[g * 4 + e];
                int i1 = 0; float v1 = el[t][0];
#pragma unroll
                for (int e = 1; e < 4; ++e) if (el[t][e] > v1) { v1 = el[t][e]; i1 = e; }
                int i2 = -1; float v2 = -3.0e38f;
#pragma unroll
                for (int e = 0; e < 4; ++e) if (e != i1 && el[t][e] > v2) { v2 = el[t][e]; i2 = e; }
                const float p2 = 1.f / (1.f + __expf(v1 - v2)), p1 = 1.f - p2;
                const int lo = i1 < i2 ? i1 : i2, hi = i1 < i2 ? i2 : i1;
                const float glo = pgv[t] * (i1 < i2 ? p1 : p2), ghi = pgv[t] * (i1 < i2 ? p2 : p1);
                const int pidx = lo == 0 ? hi - 1 : (lo == 1 ? 1 + hi : 5);
                if (F.lane == 0) { s_cls[tl] = g * 6 + pidx; s_glo[tl] = glo; s_ghi[tl] = ghi; } }
        }
        LDS_WAIT(); __syncthreads();
        if (F.tid < NCLS) { int n = 0;
            for (int i = 0; i < 64; ++i) n += (s_cls[i] == F.tid) ? 1 : 0;
            int base = 0; if (n > 0) base = (int)__hip_atomic_fetch_add((unsigned*)(F.ctl + CW_CLS + (DRY ? 2048 : 0) + 64 * F.tid), (unsigned)n, RLX_AGENT);
            s_base[F.tid] = base; }
        LDS_WAIT(); __syncthreads();
        if (F.tid < 64) { const int c = s_cls[F.tid]; int rank = 0;
            for (int i = 0; i < F.tid; ++i) rank += (s_cls[i] == c) ? 1 : 0;
            ListEnt e; e.tok = blk * 64 + F.tid; e.glo = s_glo[F.tid]; e.ghi = s_ghi[F.tid]; e.pad = 0;
            (DRY ? (ListEnt*)(F.ws + WS_END) : F.LIST())[(size_t)c * LCAP + s_base[c] + rank] = e; }
        LDS_WAIT(); __syncthreads();
    }
}
__device__ __forceinline__ void cls_experts(int cls, int& elo, int& ehi) { const int g = cls / 6, p = cls % 6; const int lo = p < 3 ? 0 : (p < 5 ? 1 : 2), hi = p < 3 ? p + 1 : (p < 5 ? p - 1 : 3); elo = 4 * g + lo; ehi = 4 * g + hi; }
__device__ __forceinline__ void moe_tab_build(Frame& F) {
    LAS int* tab = (LAS int*)(F.lds + MOETAB_OFF);
    if (F.tid == 0) { int t = 0;
        for (int c = 0; c < NCLS; ++c) { const int n = (int)__hip_atomic_load((unsigned*)(F.ctl + CW_CLS + 64 * c), RLX_AGENT); tab[c] = n; tab[32 + c] = t; t += (n + 255) >> 8; }
        tab[32 + NCLS] = t; }
    LDS_WAIT(); __syncthreads();
}
struct MoeOrderBase {
    const LAS int* tab; int G, c, ncol, nunits;
    __device__ __forceinline__ bool decode(int i, pg8::Unit& u) const {
        const long L = (long)i * G + c; if (L >= nunits) return false;
        const int wgid = pg8::xcd_remap((int)L, nunits);
        const int rt = wgid / ncol; u.pm = rt; u.pn = wgid % ncol;
        int cls = 0;
        for (int k = 1; k < NCLS; ++k) if (rt >= tab[32 + k]) cls = k;
        u.x0 = cls; u.x1 = tab[cls] - (rt - tab[32 + cls]) * 256;
        return true;
    }
};
struct UpOrder : MoeOrderBase {
    static constexpr bool GATHER = true;
    const bf16* HN; const bf16* W1T; const bf16* W3T; const ListEnt* list;
    __device__ __forceinline__ bool next(int i, pg8::Unit& u) const { return decode(i, u); }
    __device__ __forceinline__ const char* a_base(const pg8::Unit&) const { return (const char*)HN; }
    __device__ __forceinline__ void a_voff(const pg8::Unit& u, const int (&R)[2], const int (&C)[2], unsigned (&v)[2][2]) const {
        const int slot0 = (u.pm - tab[32 + u.x0]) * 256;
#pragma unroll
        for (int h = 0; h < 2; ++h)
#pragma unroll
            for (int i = 0; i < 2; ++i) { const int r = h * 128 + R[i]; int tok = 0; if (r < u.x1) tok = list[(size_t)u.x0 * LCAP + slot0 + r].tok;
                v[h][i] = (unsigned)(tok * D + C[i] * 2); }
    }
    __device__ __forceinline__ const char* b_base(const pg8::Unit& u, int half, int kt) const {
        int elo, ehi; cls_experts(u.x0, elo, ehi); const int e = u.pn < 4 ? elo : ehi;
        const bf16* W = half ? W3T : W1T;
        return (const char*)W + ((size_t)(e * FF + (u.pn & 3) * 128) * D + (size_t)kt * 128);
    }
};
struct DownOrder : MoeOrderBase {
    static constexpr bool GATHER = false;
    const bf16* HID; const bf16* W2T;
    __device__ __forceinline__ bool next(int i, pg8::Unit& u) const { return decode(i, u); }
    __device__ __forceinline__ const char* a_base(const pg8::Unit& u) const { return (const char*)HID + (size_t)u.pm * 256 * D; }
    __device__ __forceinline__ void a_voff(const pg8::Unit&, const int (&R)[2], const int (&C)[2], unsigned (&v)[2][2]) const {
#pragma unroll
        for (int h = 0; h < 2; ++h)
#pragma unroll
            for (int i = 0; i < 2; ++i) v[h][i] = (unsigned)((h * 128 + R[i]) * D + C[i] * 2);
    }
    __device__ __forceinline__ const char* b_base(const pg8::Unit& u, int half, int kt) const {
        int elo, ehi; cls_experts(u.x0, elo, ehi); const int e = kt < 4 ? elo : ehi;
        return (const char*)W2T + ((size_t)(e * D + u.pn * 256 + half * 128) * FF + (size_t)(kt & 3) * 128);
    }
};
struct EpiUp {
    static constexpr bool PERM = true;
    unsigned char* HID; const ListEnt* list; const LAS int* tab;
    __device__ __forceinline__ void operator()(const f32x4 (&acc)[2][2][4][2], const pg8::Unit& u, int wr, int wc, int fr, int fq) const {
        const int slot0 = (u.pm - tab[32 + u.x0]) * 256; const bool usehi = u.pn >= 4;
        constexpr float IS = 1.f / (SC_HN * SC_W);
#pragma unroll
        for (int ai = 0; ai < 2; ++ai)
#pragma unroll
            for (int m = 0; m < 4; ++m) { const int r = ai * 128 + wr * 64 + m * 16 + fr;
                float gate = 0.f; if (r < u.x1) { const ListEnt* e = list + (size_t)u.x0 * LCAP + slot0 + r; gate = usehi ? e->ghi : e->glo; }
                gate *= SC_HID * IS;
                const f32x4 a0 = acc[ai][0][m][0] * IS, a1 = acc[ai][0][m][1] * IS, b0 = acc[ai][1][m][0], b1 = acc[ai][1][m][1];
                float o[8];
#pragma unroll
                for (int j = 0; j < 4; ++j) { o[j] = a0[j] / (1.f + __expf(-a0[j])) * b0[j] * gate; o[4 + j] = a1[j] / (1.f + __expf(-a1[j])) * b1[j] * gate; }
                v2u w; w.x = pk4_fp8(o[0], o[1], o[2], o[3]); w.y = pk4_fp8(o[4], o[5], o[6], o[7]);
                *(v2u*)(HID + (size_t)(u.pm * 256 + r) * D + u.pn * 128 + wc * 32 + 8 * fq) = w; }
    }
};
struct EpiDown {
    static constexpr bool PERM = false;
    float* out; const ListEnt* list; const LAS int* tab;
    __device__ __forceinline__ void operator()(const f32x4 (&acc)[2][2][4][2], const pg8::Unit& u, int wr, int wc, int fr, int fq) const {
        const int slot0 = (u.pm - tab[32 + u.x0]) * 256; const int col0 = u.pn * 256 + wc * 32 + 4 * fq;
#pragma unroll
        for (int ai = 0; ai < 2; ++ai)
#pragma unroll
            for (int m = 0; m < 4; ++m) { const int r = ai * 128 + wr * 64 + m * 16 + fr;
                if (r < u.x1) { const int tok = list[(size_t)u.x0 * LCAP + slot0 + r].tok; float* rowp = out + (size_t)tok * D + col0;
#pragma unroll
                    for (int bj = 0; bj < 2; ++bj)
#pragma unroll
                        for (int n = 0; n < 2; ++n) { const f32x4 h = *(const f32x4*)(rowp + bj * 128 + n * 16); *(f32x4*)(rowp + bj * 128 + n * 16) = h + acc[ai][bj][m][n] * (1.f / (SC_HID * SC_W)); } }
                asm volatile("" ::: "memory"); }
    }
};
template <bool DRY> __device__ __forceinline__ void final_norm(Frame& F) {
    const float* gfin_ = F.g_fin();
    const int gw = F.vcu * NWAVES + F.wave, NGW = F.G * NWAVES;
    for (int m = gw; m < M; m += NGW) {
        GAS f32x4* xr = (GAS f32x4*)(F.out + (size_t)m * D) + F.lane;
        f32x4 v[4]; float s = 0.f;
#pragma unroll
        for (int j = 0; j < 4; ++j) { v[j] = xr[64 * j]; s += (v[j].x * v[j].x + v[j].y * v[j].y) + (v[j].z * v[j].z + v[j].w * v[j].w); }
        const float rstd = 1.f / sqrtf(wave_sum(s) * (1.f / D) + EPS);
#pragma unroll
        for (int j = 0; j < 4; ++j) { const f32x4 g = *(const f32x4*)(gfin_ + 4 * F.lane + 256 * j); (DRY ? (GAS f32x4*)((float*)(F.ws + WS_PROJ + 48 * MiB) + (size_t)m * D) + F.lane : xr)[64 * j] = v[j] * rstd * g; }
    }
}

constexpr int NPHASE = 9;
struct Args { const float* in[17]; float* out; unsigned char* ws; int ph_lo, ph_hi; };
__global__ void __launch_bounds__(NWAVES * 64, 2) hybrid_fwd(Args args) {
    extern __shared__ __attribute__((aligned(16))) unsigned char lds[];
    Frame F;
    F.lds = (LAS unsigned char*)lds;
    F.MISC = (volatile LAS unsigned*)(F.lds + MISC_OFF);
    F.tid = threadIdx.x; F.lane = F.tid & 63; F.wave = __builtin_amdgcn_readfirstlane(F.tid >> 6);
    F.G = gridDim.x; { const int bx = blockIdx.x; F.vcu = (F.G % 8 == 0) ? (bx % 8) * (F.G / 8) + bx / 8 : bx; }
    unsigned char* ws = args.ws; F.ws = ws; F.out = args.out;
    F.ctl = (gu32*)(ws + WS_CTL);
    for (int u = F.tid; u < (LDS_BYTES - LDSCTL_OFF) / 4; u += NWAVES * 64) ((LAS unsigned*)(F.lds + LDSCTL_OFF))[u] = 0u;
    __syncthreads();
    if (F.tid < 17) { const unsigned long long p = (unsigned long long)args.in[F.tid]; volatile LAS unsigned* t = (volatile LAS unsigned*)(F.lds + PTAB_OFF) + 2 * F.tid; t[0] = (unsigned)p; t[1] = (unsigned)(p >> 32); }
    LDS_WAIT(); __syncthreads();
#if MK_PER_PHASE
#define GRID_BAR() do { } while (0)
#else
    XcdBarrier bar = xcd_barrier_post((unsigned*)(F.ctl + CW_BAR), F.MISC + 8);
#define GRID_BAR() xcd_barrier(bar)
#endif
    const int lo = args.ph_lo, hi = args.ph_hi;
#ifndef PHASE_MASK
#define PHASE_MASK 0x1ff
#endif
#define IN(k) (((PHASE_MASK >> (k)) & 1) && lo <= (k) && (k) < hi)
#define BOTH(k) (IN(k) && IN((k) + 1))

#ifndef REP_MASK
#define REP_MASK 0
#endif
#define RUNPH(k, BODY) do { if (IN(k)) { BODY(); if ((REP_MASK >> (k)) & 1) { GRID_BAR(); BODY(); } if (BOTH(k)) GRID_BAR(); } } while (0)
#ifndef PROBE_X
#define PROBE_X 0
#endif
#define PH0() do { p0_prologue(F); } while (0)
#define PH1() do { pg8::DenseOrder S; S.init(F.XN(), F.WinT(), M, PW, D, D, F.G, (int)blockIdx.x); pg8::EpiBf16 E{F.PROJ(), PW}; \
        pg8::gemm_phase<pg8::EpiBf16, pg8::DenseOrder, true, true>(F.lds + RING_OFF, S, E, 2 * D, D / 64); expert_convert_queue(F); } while (0)
#define PH2() do { if (PROBE_X == 23) mx::attn_phase<1>(F); if (PROBE_X == 24) mx::attn_phase<2>(F); mx::attn_phase<0>(F); if (PROBE_X == 21) mx::attn_phase<0>(F); mx::ret_kv_phase(F); if (PROBE_X == 22) mx::ret_kv_phase(F); } while (0)
#define PH3() do { mx::ret_out_phase(F); if (PROBE_X == 31) mx::ret_out_phase(F); attn_combine(F); if (PROBE_X == 32) attn_combine(F); } while (0)
#define PH4() do { pg8::DenseOrder S; S.init(F.MIX(), F.WoutT(), M, D, D, D, F.G, (int)blockIdx.x); pg8::EpiResF32 E{F.x(), F.out, D}; \
        pg8::gemm_phase<pg8::EpiResF32, pg8::DenseOrder, true, true>(F.lds + RING_OFF, S, E, 2 * D, D / 64); } while (0)
#define PH5() do { if (PROBE_X == 5) { router<true>(F); GRID_BAR(); } router<false>(F); } while (0)
#define PH6() do { moe_tab_build(F); const LAS int* tab = (const LAS int*)(F.lds + MOETAB_OFF); \
        UpOrder S; S.tab = tab; S.G = F.G; S.c = (int)blockIdx.x; S.ncol = 8; S.nunits = tab[32 + NCLS] * 8; S.HN = F.XN(); S.W1T = F.W1T(); S.W3T = F.W3T(); S.list = F.LIST(); \
        EpiUp E{(unsigned char*)F.HID(), F.LIST(), tab}; pg8::gemm_phase<EpiUp, UpOrder, true, true, true>(F.lds + RING_OFF, S, E, D, 8); } while (0)
#define PH7() do { moe_tab_build(F); const LAS int* tab = (const LAS int*)(F.lds + MOETAB_OFF); \
        DownOrder S; S.tab = tab; S.G = F.G; S.c = (int)blockIdx.x; S.ncol = 4; S.nunits = tab[32 + NCLS] * 4; S.HID = F.HID(); S.W2T = F.W2T(); \
        if (PROBE_X == 7) { EpiDown E0{(float*)(F.ws + WS_PROJ + 48 * MiB), F.LIST(), tab}; pg8::gemm_phase<EpiDown, DownOrder, true, true, true>(F.lds + RING_OFF, S, E0, FF, 8); GRID_BAR(); } \
        EpiDown E{F.out, F.LIST(), tab}; pg8::gemm_phase<EpiDown, DownOrder, true, true, true>(F.lds + RING_OFF, S, E, FF, 8); } while (0)
#define PH8() do { if (PROBE_X == 8) { final_norm<true>(F); GRID_BAR(); } final_norm<false>(F); } while (0)
    RUNPH(0, PH0); RUNPH(1, PH1); RUNPH(2, PH2); RUNPH(3, PH3); RUNPH(4, PH4); RUNPH(5, PH5); RUNPH(6, PH6); RUNPH(7, PH7); RUNPH(8, PH8);
#undef IN
#undef BOTH
}

extern "C" void kernel_launch(void* const* d_in, const int* in_sizes, int n_in, void* d_out, int out_size, void* d_ws, size_t ws_size, hipStream_t stream) {
    static int grid = 0;
    if (grid == 0) {
        if (n_in != 17 || in_sizes[0] != M * D || out_size != M * D || ws_size < WS_END) { fprintf(stderr, "kernel_launch: unexpected shapes (n_in %d, in0 %d, out %d, ws %zu)\n", n_in, n_in > 0 ? in_sizes[0] : -1, out_size, ws_size); grid = -1; return; }
        int dev = 0, cus = 0, per_cu = 0;
        if (hipGetDevice(&dev) != hipSuccess || hipDeviceGetAttribute(&cus, hipDeviceAttributeMultiprocessorCount, dev) != hipSuccess) { grid = -1; return; }
        if (hipFuncSetAttribute((const void*)hybrid_fwd, hipFuncAttributeMaxDynamicSharedMemorySize, LDS_BYTES) != hipSuccess) { fprintf(stderr, "kernel_launch: hipFuncSetAttribute failed\n"); grid = -1; return; }
        if (hipOccupancyMaxActiveBlocksPerMultiprocessor(&per_cu, (const void*)hybrid_fwd, NWAVES * 64, LDS_BYTES) != hipSuccess || per_cu < 1)
            fprintf(stderr, "kernel_launch: note: occupancy query reports %d workgroups per CU\n", per_cu);
        (void)hipGetLastError();
        grid = cus;
    }
    if (grid < 0) return;
    if (hipMemsetAsync((char*)d_ws + WS_CTL, 0, CTL_ZERO_BYTES, stream) != hipSuccess) return;
    Args a{};
    for (int i = 0; i < 17; ++i) a.in[i] = (const float*)d_in[i];
    a.out = (float*)d_out; a.ws = (unsigned char*)d_ws;
#if MK_PER_PHASE
    for (int p = 0; p < NPHASE; ++p) { a.ph_lo = p; a.ph_hi = p + 1; hipLaunchKernelGGL(hybrid_fwd, dim3(grid), dim3(NWAVES * 64), LDS_BYTES, stream, a); }
#else
    a.ph_lo = 0; a.ph_hi = NPHASE; hipLaunchKernelGGL(hybrid_fwd, dim3(grid), dim3(NWAVES * 64), LDS_BYTES, stream, a);
#endif
}
```
